# Optimizing an MI355X kernel written in HIP

```python
import jax, jax.numpy as jnp
from jax import lax
import numpy as np

D_MODEL = 1024
BATCH = 16
SEQ = 2048
DEPTH = 2
DEC_BATCH = 2
DEC_SEQ = 16384
PAST_LEN = 128

N_META = 16
MIX_WIDTH = D_MODEL
MLA_HEADS = 4
QK_NOPE = 128
QK_ROPE = 64
V_HEAD = 128
MLA_WIDTH = MLA_HEADS * V_HEAD
CONV_WIDTH = MIX_WIDTH - MLA_WIDTH
CONV_K = 3
Q_LORA = 384
KV_LORA = 256
D_FF = -(-8 * D_MODEL // (3 * 256)) * 256
IN_COLS = Q_LORA + KV_LORA + QK_ROPE + 3 * CONV_WIDTH
ROPE_THETA = 10000.0
EPS = 1e-6
Q_BLOCK = 128
ATTN_SCALE = (QK_NOPE + QK_ROPE) ** -0.5

kernel_name = "hymba_mla_shortconv_encoder"


def rmsnorm(x, g):
    xf = x.astype(jnp.float32)
    y = xf * lax.rsqrt(jnp.mean(xf * xf, axis=-1, keepdims=True) + EPS)
    return (y * g.astype(jnp.float32)).astype(x.dtype)


def rope_tables(length, dtype):
    inv_freq = ROPE_THETA ** (-jnp.arange(0, QK_ROPE, 2, dtype=jnp.float32) / QK_ROPE)
    ang = jnp.arange(length, dtype=jnp.float32)[:, None] * inv_freq[None, :]
    return jnp.cos(ang).astype(dtype), jnp.sin(ang).astype(dtype)


def apply_rope(x, cos, sin):
    half = QK_ROPE // 2
    x1, x2 = x[..., :half], x[..., half:]
    return jnp.concatenate([x1 * cos - x2 * sin, x2 * cos + x1 * sin], axis=-1)


def mla_attention(q_nope, q_rope, k_nope, k_rope, v):
    b, l, h, _ = q_nope.shape

    def attend(qn, qr):
        s = (jnp.einsum('bqhd,bkhd->bhqk', qn, k_nope)
             + jnp.einsum('bqhr,bkr->bhqk', qr, k_rope))
        p = jax.nn.softmax(s.astype(jnp.float32) * ATTN_SCALE, axis=-1).astype(v.dtype)
        return jnp.einsum('bhqk,bkhd->bqhd', p, v)

    out_meta = attend(q_nope[:, :N_META], q_rope[:, :N_META])
    n_blk = (l - N_META) // Q_BLOCK
    qn = jnp.moveaxis(q_nope[:, N_META:].reshape(b, n_blk, Q_BLOCK, h, QK_NOPE), 1, 0)
    qr = jnp.moveaxis(q_rope[:, N_META:].reshape(b, n_blk, Q_BLOCK, h, QK_ROPE), 1, 0)
    out_real = lax.map(lambda a: attend(a[0], a[1]), (qn, qr))
    out_real = jnp.moveaxis(out_real, 0, 1).reshape(b, l - N_META, h, V_HEAD)
    out = jnp.concatenate([out_meta, out_real], axis=1)
    return out.reshape(b, l, h * V_HEAD)


def short_conv(u, w):
    l = u.shape[1]
    pad = CONV_K // 2
    up = jnp.pad(u, ((0, 0), (pad, pad), (0, 0)))
    y = up[:, 0:l] * w[0]
    for k in range(1, CONV_K):
        y = y + up[:, k:k + l] * w[k]
    return y


def layer(x, pre_mix_g, w_in, q_norm_g, w_q_up, kv_norm_g, w_kv_up, conv_w, w_out,
          post_mix_g, pre_ffn_g, w_gate, w_up, w_down, post_ffn_g):
    b, l, _ = x.shape
    h = rmsnorm(x, pre_mix_g)
    z = h @ w_in
    i0 = Q_LORA
    i1 = i0 + KV_LORA
    i2 = i1 + QK_ROPE
    i3 = i2 + CONV_WIDTH
    i4 = i3 + CONV_WIDTH
    c_q, c_kv, k_r = z[..., :i0], z[..., i0:i1], z[..., i1:i2]
    g_b, g_c, c_h = z[..., i2:i3], z[..., i3:i4], z[..., i4:]

    q = (rmsnorm(c_q, q_norm_g) @ w_q_up).reshape(b, l, MLA_HEADS, QK_NOPE + QK_ROPE)
    kv = (rmsnorm(c_kv, kv_norm_g) @ w_kv_up).reshape(b, l, MLA_HEADS, QK_NOPE + V_HEAD)
    cos, sin = rope_tables(l, x.dtype)
    q_nope = q[..., :QK_NOPE]
    q_rope = apply_rope(q[..., QK_NOPE:], cos[None, :, None, :], sin[None, :, None, :])
    k_nope, v = kv[..., :QK_NOPE], kv[..., QK_NOPE:]
    k_rope = apply_rope(k_r, cos[None], sin[None])
    attn_out = mla_attention(q_nope, q_rope, k_nope, k_rope, v)

    conv_out = g_b * short_conv(g_c * c_h, conv_w)

    mix = jnp.concatenate([attn_out, conv_out], axis=-1) @ w_out
    x = x + rmsnorm(mix, post_mix_g)

    h = rmsnorm(x, pre_ffn_g)
    f = (jax.nn.silu(h @ w_gate) * (h @ w_up)) @ w_down
    return x + rmsnorm(f, post_ffn_g)


def trunk(x, meta_tokens, pre_mix_g, w_in, q_norm_g, w_q_up, kv_norm_g, w_kv_up, conv_w,
          w_out, post_mix_g, pre_ffn_g, w_gate, w_up, w_down, post_ffn_g):
    b = x.shape[0]
    meta = jnp.broadcast_to(meta_tokens.astype(x.dtype)[None], (b, N_META, D_MODEL))
    x = jnp.concatenate([meta, x], axis=1)
    for i in range(DEPTH):
        x = layer(x, pre_mix_g[i], w_in[i], q_norm_g[i], w_q_up[i], kv_norm_g[i], w_kv_up[i],
                  conv_w[i], w_out[i], post_mix_g[i], pre_ffn_g[i], w_gate[i], w_up[i],
                  w_down[i], post_ffn_g[i])
    return x[:, N_META:]


def setup_inputs(seed: int = 0) -> dict:
    key = jax.random.key(seed)
    ks = jax.random.split(key, 20)
    f32 = jnp.float32

    def nrm(k, shape, scale):
        return jax.random.normal(k, shape, f32) * scale

    def gain(k, shape):
        return 1.0 + 0.05 * jax.random.normal(k, shape, f32)

    return {
        "x_prompt": nrm(ks[0], (BATCH, SEQ, D_MODEL), 1.0),
        "x_sample": nrm(ks[1], (DEC_BATCH, DEC_SEQ, D_MODEL), 1.0),
        "meta_tokens": nrm(ks[2], (N_META, D_MODEL), 1.0),
        "pre_mix_g": gain(ks[3], (DEPTH, D_MODEL)),
        "w_in": nrm(ks[4], (DEPTH, D_MODEL, IN_COLS), D_MODEL ** -0.5),
        "q_norm_g": gain(ks[5], (DEPTH, Q_LORA)),
        "w_q_up": nrm(ks[6], (DEPTH, Q_LORA, MLA_HEADS * (QK_NOPE + QK_ROPE)), Q_LORA ** -0.5),
        "kv_norm_g": gain(ks[7], (DEPTH, KV_LORA)),
        "w_kv_up": nrm(ks[8], (DEPTH, KV_LORA, MLA_HEADS * (QK_NOPE + V_HEAD)), KV_LORA ** -0.5),
        "conv_w": nrm(ks[9], (DEPTH, CONV_K, CONV_WIDTH), CONV_K ** -0.5),
        "w_out": nrm(ks[10], (DEPTH, MIX_WIDTH, D_MODEL), MIX_WIDTH ** -0.5),
        "post_mix_g": gain(ks[11], (DEPTH, D_MODEL)),
        "pre_ffn_g": gain(ks[12], (DEPTH, D_MODEL)),
        "w_gate": nrm(ks[13], (DEPTH, D_MODEL, D_FF), D_MODEL ** -0.5),
        "w_up": nrm(ks[14], (DEPTH, D_MODEL, D_FF), D_MODEL ** -0.5),
        "w_down": nrm(ks[15], (DEPTH, D_FF, D_MODEL), D_FF ** -0.5),
        "post_ffn_g": gain(ks[16], (DEPTH, D_MODEL)),
    }


def reference(x_prompt, x_sample, meta_tokens, pre_mix_g, w_in, q_norm_g, w_q_up, kv_norm_g,
              w_kv_up, conv_w, w_out, post_mix_g, pre_ffn_g, w_gate, w_up, w_down, post_ffn_g):
    y_prompt = trunk(x_prompt, meta_tokens, pre_mix_g, w_in, q_norm_g, w_q_up, kv_norm_g,
                     w_kv_up, conv_w, w_out, post_mix_g, pre_ffn_g, w_gate, w_up, w_down,
                     post_ffn_g)
    y_sample = trunk(x_sample, meta_tokens, pre_mix_g, w_in, q_norm_g, w_q_up, kv_norm_g,
                     w_kv_up, conv_w, w_out, post_mix_g, pre_ffn_g, w_gate, w_up, w_down,
                     post_ffn_g)
    return (y_prompt, y_sample)
```

```cpp
#include <hip/hip_runtime.h>
#include <hip/hip_cooperative_groups.h>
#include <cstdio>
#include <cstdint>
namespace cg = cooperative_groups;

#ifndef PHM
#define PHM 511
#endif
#ifndef MK_N_LAUNCHES
#define MK_N_LAUNCHES 1
#endif

constexpr int DM = 1024, DFF = 2816, NLAYER = 2;
constexpr int L_P = 2064, L_S = 16400, NSEQ_P = 16, NSEQ_S = 2;
constexpr int ROWS_P = NSEQ_P * L_P;
constexpr int M_REAL = ROWS_P + NSEQ_S * L_S;
constexpr int MP = 66048;
constexpr int NZ = 2304;
constexpr float EPS = 1e-6f;
static_assert(MP % 256 == 0 && MP >= M_REAL, "row padding");

namespace pg8 {
#define PG8_LAS __attribute__((address_space(3)))
typedef unsigned short bf16_t;
typedef short bf16x8 __attribute__((ext_vector_type(8)));
typedef float f32x4 __attribute__((ext_vector_type(4)));
typedef unsigned u32x4 __attribute__((ext_vector_type(4)));
constexpr int BM = 256, BK = 64, HALF = 128, HTB = HALF * BK * 2  , STAGE_BYTES = 8 * HTB, NXCD = 8, WGM = 8;

__host__ __device__ __forceinline__ int lds_byte(int r, int c) { const int st = (r >> 4) * 2 + (c >> 5), rr = r & 15, cc = c & 31, ob = rr * 64 + cc * 2; return st * 1024 + (ob ^ (((ob >> 9) & 1) << 5)); }
__host__ __device__ __forceinline__ void stage_rc(int b, int& R, int& C) { const int st = b / 1024, sb = b % 1024, swz = sb ^ (((sb >> 9) & 1) << 5); R = (st >> 1) * 16 + swz / 64; C = (st & 1) * 32 + (swz % 64) / 2; }
__host__ __device__ __forceinline__ int perm32(int rho) { const int n = rho >> 4, i = rho & 15; return 8 * (i >> 2) + 4 * n + (i & 3); }

struct Unit { int pm, pn; };
struct Gemm { const bf16_t* A; const bf16_t* A2; int pm_split; const bf16_t* Bt; int M, N, K, lda; };

struct StaticOrder {
    int nM, nN, nwg, G, c;
    __host__ __device__ void init(int M, int N, int G_, int c_) { nM = M / BM; nN = N / BM; nwg = nM * nN; G = G_; c = c_; }
    __host__ __device__ bool next(int i, Unit& u) const {
        const long L = (long)i * G + c; if (L >= nwg) return false;
        int wgid = (int)L; { const int q = nwg / NXCD, r = nwg % NXCD, xcd = wgid % NXCD, off = wgid / NXCD; wgid = (xcd < r ? xcd * (q + 1) : r * (q + 1) + (xcd - r) * q) + off; }
        const int nig = WGM * nN, gid = wgid / nig, fm = gid * WGM, gsz = (nM - fm) < WGM ? (nM - fm) : WGM;
        u.pm = fm + ((wgid % nig) % gsz); u.pn = (wgid % nig) / gsz; return true;
    }
    __device__ __forceinline__ void a_ready(const Unit&) const {}
    __device__ __forceinline__ void done(const Unit&) const {}
};


__device__ __forceinline__ unsigned cvt_pk_bf16(float lo, float hi) { unsigned r; asm volatile("v_cvt_pk_bf16_f32 %0, %1, %2" : "=v"(r) : "v"(lo), "v"(hi)); return r; }
__device__ __forceinline__ void st8(bf16_t* p, f32x4 a, f32x4 b) { u32x4 w; w.x = cvt_pk_bf16(a[0], a[1]); w.y = cvt_pk_bf16(a[2], a[3]); w.z = cvt_pk_bf16(b[0], b[1]); w.w = cvt_pk_bf16(b[2], b[3]); *(u32x4*)p = w; }
__device__ __forceinline__ float ssq4(f32x4 a) { return (a[0] * a[0] + a[1] * a[1]) + (a[2] * a[2] + a[3] * a[3]); }
__device__ __forceinline__ float red_fq(float p) { p += __shfl_xor(p, 16); p += __shfl_xor(p, 32); return p; }
__device__ __forceinline__ int row_pos(int r) {
    int pos;
    if (r < ROWS_P) pos = r % L_P; else { pos = (r - ROWS_P) % L_S; }
    return pos;
}

struct EpiZ {
    static constexpr bool PERM = true, AFTER_DRAIN = false;
    bf16_t* ZQ; bf16_t* GB; bf16_t* U; float* SSQ; const float* ssqX;
    __device__ __forceinline__ void operator()(const f32x4 (&acc)[2][2][4][2], const Unit& u, int wr, int wc, int fr, int fq) const {
        asm volatile("" : "+v"(fr), "+v"(fq)); asm volatile("" : "+s"(wr), "+s"(wc));
        const int row0 = u.pm * BM + wr * 64 + fr, pn = u.pn, cw = wc * 32 + fq * 8;
#pragma unroll
        for (int ai = 0; ai < 2; ++ai)
#pragma unroll
            for (int m = 0; m < 4; ++m) {
                const int row = row0 + ai * HALF + m * 16;
                const float s = rsqrtf(ssqX[row] * (1.0f / 1024.0f) + EPS);
                const f32x4 a0 = acc[ai][0][m][0] * s, a1 = acc[ai][0][m][1] * s, b0 = acc[ai][1][m][0] * s, b1 = acc[ai][1][m][1] * s;
                if (pn < 3) {
                    bf16_t* p = ZQ + (size_t)row * 768 + pn * 256 + cw;
                    st8(p, a0, a1); st8(p + HALF, b0, b1);
                    const float pa = red_fq(ssq4(a0) + ssq4(a1)), pb = red_fq(ssq4(b0) + ssq4(b1));
                    if (fq == 0) { SSQ[(size_t)row * 32 + pn * 8 + wc] = pa; SSQ[(size_t)row * 32 + pn * 8 + 4 + wc] = pb; }
                } else if (pn < 5) {
                    bf16_t* p = GB + (size_t)row * 512 + (pn - 3) * 256 + cw;
                    st8(p, a0, a1); st8(p + HALF, b0, b1);
                } else {
                    bf16_t* p = U + (size_t)row * 512 + (pn - 5) * 128 + cw;
                    st8(p, a0 * b0, a1 * b1);
                }
                asm volatile("" ::: "memory");
            }
    }
};
struct EpiQ {
    static constexpr bool PERM = true, AFTER_DRAIN = false;
    bf16_t* Q; const float* SSQ; const float* ROPE;
    __device__ __forceinline__ void operator()(const f32x4 (&acc)[2][2][4][2], const Unit& u, int wr, int wc, int fr, int fq) const {
        asm volatile("" : "+v"(fr), "+v"(fq)); asm volatile("" : "+s"(wr), "+s"(wc));
        const int row0 = u.pm * BM + wr * 64 + fr, pn = u.pn, cw = wc * 32 + fq * 8;
#pragma unroll
        for (int ai = 0; ai < 2; ++ai)
#pragma unroll
            for (int m = 0; m < 4; ++m) {
                const int row = row0 + ai * HALF + m * 16;
                const f32x4* sp = (const f32x4*)(SSQ + (size_t)row * 32);
                const f32x4 s0 = sp[0], s1 = sp[1], s2 = sp[2];
                const float ss = ((s0[0] + s0[1]) + (s0[2] + s0[3])) + ((s1[0] + s1[1]) + (s1[2] + s1[3])) + ((s2[0] + s2[1]) + (s2[2] + s2[3]));
                const float s = rsqrtf(ss * (1.0f / 384.0f) + EPS);
                const f32x4 a0 = acc[ai][0][m][0] * s, a1 = acc[ai][0][m][1] * s, b0 = acc[ai][1][m][0] * s, b1 = acc[ai][1][m][1] * s;
                bf16_t* qrow = Q + (size_t)row * 768;
                if (pn < 2) { st8(qrow + pn * 256 + cw, a0, a1); st8(qrow + pn * 256 + HALF + cw, b0, b1); }
                else {
                    const int pos = row_pos(row);
                    const f32x4* cp = (const f32x4*)(ROPE + (size_t)pos * 64 + fq * 8);
                    const f32x4 c0 = cp[0], c1 = cp[1], n0 = cp[8], n1 = cp[9];
                    st8(qrow + 512 + cw, a0 * c0 - b0 * n0, a1 * c1 - b1 * n1);
                    st8(qrow + 640 + cw, b0 * c0 + a0 * n0, b1 * c1 + a1 * n1);
                }
                asm volatile("" ::: "memory");
            }
    }
};
struct EpiKV {
    static constexpr bool PERM = true, AFTER_DRAIN = false;
    bf16_t* KN; bf16_t* V; const float* SSQ;
    __device__ __forceinline__ void operator()(const f32x4 (&acc)[2][2][4][2], const Unit& u, int wr, int wc, int fr, int fq) const {
        asm volatile("" : "+v"(fr), "+v"(fq)); asm volatile("" : "+s"(wr), "+s"(wc));
        const int row0 = u.pm * BM + wr * 64 + fr, pn = u.pn, cw = wc * 32 + fq * 8;
        bf16_t* base = (pn < 2) ? KN + pn * 256 : V + (pn - 2) * 256;
#pragma unroll
        for (int ai = 0; ai < 2; ++ai)
#pragma unroll
            for (int m = 0; m < 4; ++m) {
                const int row = row0 + ai * HALF + m * 16;
                const f32x4* sp = (const f32x4*)(SSQ + (size_t)row * 32);
                const f32x4 s0 = sp[3], s1 = sp[4];
                const float ss = ((s0[0] + s0[1]) + (s0[2] + s0[3])) + ((s1[0] + s1[1]) + (s1[2] + s1[3]));
                const float s = rsqrtf(ss * (1.0f / 256.0f) + EPS);
                bf16_t* p = base + (size_t)row * 512 + cw;
                st8(p, acc[ai][0][m][0] * s, acc[ai][0][m][1] * s); st8(p + HALF, acc[ai][1][m][0] * s, acc[ai][1][m][1] * s);
                asm volatile("" ::: "memory");
            }
    }
};
struct EpiMix {
    static constexpr bool PERM = true, AFTER_DRAIN = false;
    bf16_t* OUT; float* SSQ;
    __device__ __forceinline__ void operator()(const f32x4 (&acc)[2][2][4][2], const Unit& u, int wr, int wc, int fr, int fq) const {
        asm volatile("" : "+v"(fr), "+v"(fq)); asm volatile("" : "+s"(wr), "+s"(wc));
        const int row0 = u.pm * BM + wr * 64 + fr, pn = u.pn, cw = wc * 32 + fq * 8;
#pragma unroll
        for (int ai = 0; ai < 2; ++ai)
#pragma unroll
            for (int m = 0; m < 4; ++m) {
                const int row = row0 + ai * HALF + m * 16;
                const f32x4 a0 = acc[ai][0][m][0], a1 = acc[ai][0][m][1], b0 = acc[ai][1][m][0], b1 = acc[ai][1][m][1];
                bf16_t* p = OUT + (size_t)row * 1024 + pn * 256 + cw;
                st8(p, a0, a1); st8(p + HALF, b0, b1);
                const float pa = red_fq(ssq4(a0) + ssq4(a1)), pb = red_fq(ssq4(b0) + ssq4(b1));
                if (fq == 0) { SSQ[(size_t)row * 32 + pn * 8 + wc] = pa; SSQ[(size_t)row * 32 + pn * 8 + 4 + wc] = pb; }
            }
    }
};
struct EpiAct {
    static constexpr bool PERM = true, AFTER_DRAIN = false;
    bf16_t* ACT1; bf16_t* ACT2; int pm_split; const float* ssqX;
    __device__ __forceinline__ void operator()(const f32x4 (&acc)[2][2][4][2], const Unit& u, int wr, int wc, int fr, int fq) const {
        asm volatile("" : "+v"(fr), "+v"(fq)); asm volatile("" : "+s"(wr), "+s"(wc));
        const int rl0 = wr * 64 + fr, pn = u.pn, cw = wc * 32 + fq * 8;
        bf16_t* base = (u.pm < pm_split) ? ACT1 + (size_t)u.pm * BM * 2816 : ACT2 + (size_t)(u.pm - pm_split) * BM * 2816;
#pragma unroll
        for (int ai = 0; ai < 2; ++ai)
#pragma unroll
            for (int m = 0; m < 4; ++m) {
                const int rl = rl0 + ai * HALF + m * 16;
                const float s = rsqrtf(ssqX[u.pm * BM + rl] * (1.0f / 1024.0f) + EPS);
                f32x4 o[2];
#pragma unroll
                for (int n = 0; n < 2; ++n) {
                    const f32x4 g = acc[ai][0][m][n] * s, up = acc[ai][1][m][n] * s;
#pragma unroll
                    for (int j = 0; j < 4; ++j) { const float e = __builtin_amdgcn_exp2f(g[j] * -1.4426950408889634f); o[n][j] = g[j] * __builtin_amdgcn_rcpf(1.0f + e) * up[j]; }
                }
                st8(base + (size_t)rl * 2816 + pn * 128 + cw, o[0], o[1]);
                asm volatile("" ::: "memory");
            }
    }
};

template <class Epi, class Sched, bool ALIGN_EPI = false, bool SP2 = false>
__device__ __forceinline__ void gemm_phase(PG8_LAS unsigned char* lds, const Gemm g, const Sched& S, const Epi& E) {
    int tid = threadIdx.x; asm volatile("" : "+v"(tid));
    const int wid = __builtin_amdgcn_readfirstlane(tid >> 6), lane = tid & 63, wr = wid >> 2, wc = wid & 3, fr = lane & 15, fq = lane >> 4;
    int K = g.K; asm volatile("" : "+s"(K));
    const int nt = K / BK;
    unsigned voffA[2], voffB[2];
#pragma unroll
    for (int i = 0; i < 2; ++i) { int R, C; stage_rc(tid * 16 + i * 8192, R, C); const int Rb = Epi::PERM ? ((R & ~31) + perm32(R & 31)) : R;
        voffA[i] = (unsigned)(R * g.lda + C) * 2u; voffB[i] = (unsigned)(Rb * K + C) * 2u; }
    const size_t kstep = (size_t)(BK * 2);
    const size_t hstepA = (size_t)HALF * g.lda * 2, hstepB = (size_t)HALF * K * 2;
    const size_t tstepA = 2 * hstepA, tstepB = 2 * hstepB;
    const unsigned ldsw = (unsigned)wid * 1024u;
    const int aoff = lds_byte(wr * 64 + fr, fq * 8), boff = lds_byte(wc * 32 + fr, fq * 8);
#define PG8_SA(b, h) (((b) * 2 + (h)) * HTB)
#define PG8_SB(b, h) ((4 + (b) * 2 + (h)) * HTB)
#define PG8_STAGE(bufoff, gbase, voff) do { _Pragma("unroll") for (int _i = 0; _i < 2; ++_i) \
        __builtin_amdgcn_global_load_lds((const unsigned*)((const char*)(gbase) + (voff)[_i]), (PG8_LAS unsigned*)(lds + (bufoff) + ldsw + _i * 8192), 16, 0, 0); } while (0)
#define PG8_LDA(dst, b, h) do { _Pragma("unroll") for (int m = 0; m < 4; ++m) _Pragma("unroll") for (int k = 0; k < 2; ++k) dst[m][k] = *(const PG8_LAS bf16x8*)(lds + PG8_SA(b, h) + aoff + m * 2048 + k * 1024); } while (0)
#define PG8_LDB(dst, b, h) do { _Pragma("unroll") for (int n = 0; n < 2; ++n) _Pragma("unroll") for (int k = 0; k < 2; ++k) dst[n][k] = *(const PG8_LAS bf16x8*)(lds + PG8_SB(b, h) + boff + n * 2048 + k * 1024); } while (0)
#define PG8_MMA(ai, bj, At, Bt) do { __builtin_amdgcn_s_setprio(1); _Pragma("unroll") for (int m = 0; m < 4; ++m) _Pragma("unroll") for (int n = 0; n < 2; ++n) _Pragma("unroll") for (int k = 0; k < 2; ++k) \
        acc[ai][bj][m][n] = __builtin_amdgcn_mfma_f32_16x16x32_bf16(Bt[n][k], At[m][k], acc[ai][bj][m][n], 0, 0, 0); __builtin_amdgcn_s_setprio(0); } while (0)
#define PG8_WAIT_V(n) asm volatile("s_waitcnt vmcnt(" #n ")" ::: "memory")
#define PG8_WAIT_L(n) asm volatile("s_waitcnt lgkmcnt(" #n ")" ::: "memory")
#define PG8_BAR __builtin_amdgcn_s_barrier()
#define PG8_SCHED __builtin_amdgcn_sched_barrier(0)
    Unit cur, nxt; int ui = 0;
    if (!S.next(0, cur)) return;
    f32x4 acc[2][2][4][2];
#pragma unroll
    for (int a = 0; a < 2; ++a)
#pragma unroll
        for (int b = 0; b < 2; ++b)
#pragma unroll
            for (int m = 0; m < 4; ++m)
#pragma unroll
                for (int n = 0; n < 2; ++n) acc[a][b][m][n] = (f32x4){0.f, 0.f, 0.f, 0.f};
    bf16x8 At[4][2], B0[2][2], B1[2][2];
    const char* cA = (cur.pm < g.pm_split) ? (const char*)g.A + (size_t)cur.pm * tstepA : (const char*)g.A2 + (size_t)(cur.pm - g.pm_split) * tstepA; const char* cB = (const char*)g.Bt + (size_t)cur.pn * tstepB;
    S.a_ready(cur);
    if constexpr (SP2) {
        PG8_STAGE(PG8_SB(0, 0), cB, voffB); PG8_STAGE(PG8_SB(0, 1), cB + hstepB, voffB); PG8_STAGE(PG8_SA(0, 0), cA, voffA); PG8_STAGE(PG8_SA(0, 1), cA + hstepA, voffA);
        if (wr == 1) PG8_BAR;
        PG8_WAIT_V(2); PG8_BAR;
        PG8_STAGE(PG8_SB(1, 0), cB + kstep, voffB); PG8_STAGE(PG8_SA(1, 0), cA + kstep, voffA); PG8_STAGE(PG8_SB(1, 1), cB + hstepB + kstep, voffB);
        PG8_WAIT_V(6); PG8_BAR;
    } else {
        PG8_STAGE(PG8_SB(0, 0), cB, voffB); PG8_STAGE(PG8_SA(0, 0), cA, voffA); PG8_STAGE(PG8_SB(0, 1), cB + hstepB, voffB); PG8_STAGE(PG8_SA(0, 1), cA + hstepA, voffA);
        if (wr == 1) PG8_BAR;
        PG8_WAIT_V(4); PG8_BAR;
        PG8_STAGE(PG8_SB(1, 0), cB + kstep, voffB); PG8_STAGE(PG8_SA(1, 0), cA + kstep, voffA); PG8_STAGE(PG8_SB(1, 1), cB + hstepB + kstep, voffB);
        PG8_WAIT_V(6); PG8_BAR;
    }
    for (;;) {
        const bool has_next = S.next(ui + 1, nxt);
        const char* nA = has_next ? ((nxt.pm < g.pm_split) ? (const char*)g.A + (size_t)nxt.pm * tstepA : (const char*)g.A2 + (size_t)(nxt.pm - g.pm_split) * tstepA) : cA; const char* nB = has_next ? (const char*)g.Bt + (size_t)nxt.pn * tstepB : cB;
        for (int t = 0; t < nt; t += 2) {
            const bool last = (t == nt - 2);
            const char* a1 = cA + (size_t)(t + 1) * kstep;
            const char* a2 = last ? nA : cA + (size_t)(t + 2) * kstep; const char* b2 = last ? nB : cB + (size_t)(t + 2) * kstep;
            const char* a3 = a2 + kstep; const char* b3 = b2 + kstep;
            if (last && has_next) S.a_ready(nxt);
            if constexpr (SP2) {
            PG8_LDB(B0, 0, 0); PG8_LDB(B1, 0, 1); PG8_SCHED; PG8_LDA(At, 0, 0); PG8_STAGE(PG8_SA(1, 1), a1 + hstepA, voffA);
            PG8_WAIT_V(8); PG8_WAIT_L(0); PG8_BAR; PG8_MMA(0, 0, At, B0); PG8_MMA(0, 1, At, B1); PG8_BAR; PG8_SCHED;
            PG8_LDA(At, 0, 1); PG8_STAGE(PG8_SB(0, 0), b2, voffB); PG8_STAGE(PG8_SB(0, 1), b2 + hstepB, voffB); PG8_STAGE(PG8_SA(0, 0), a2, voffA);
            PG8_WAIT_V(8); PG8_WAIT_L(0); PG8_BAR; PG8_MMA(1, 0, At, B0); PG8_MMA(1, 1, At, B1); PG8_BAR; PG8_SCHED;
            PG8_LDB(B0, 1, 0); PG8_LDB(B1, 1, 1); PG8_SCHED; PG8_LDA(At, 1, 0); PG8_STAGE(PG8_SA(0, 1), a2 + hstepA, voffA);
            PG8_WAIT_V(8); PG8_WAIT_L(0); PG8_BAR; PG8_MMA(0, 0, At, B0); PG8_MMA(0, 1, At, B1); PG8_BAR; PG8_SCHED;
            PG8_LDA(At, 1, 1); PG8_STAGE(PG8_SB(1, 0), b3, voffB); PG8_STAGE(PG8_SB(1, 1), b3 + hstepB, voffB); PG8_STAGE(PG8_SA(1, 0), a3, voffA);
            PG8_WAIT_V(8); PG8_WAIT_L(0); PG8_BAR; PG8_MMA(1, 0, At, B0); PG8_MMA(1, 1, At, B1); PG8_BAR; PG8_SCHED;
            } else {
            PG8_LDB(B0, 0, 0); PG8_SCHED; PG8_LDA(At, 0, 0); PG8_STAGE(PG8_SA(1, 1), a1 + hstepA, voffA);
            PG8_WAIT_L(8); PG8_BAR; PG8_WAIT_L(0); PG8_MMA(0, 0, At, B0); PG8_BAR; PG8_SCHED;
            PG8_LDB(B1, 0, 1); PG8_STAGE(PG8_SB(0, 0), b2, voffB);
            PG8_BAR; PG8_WAIT_L(0); PG8_MMA(0, 1, At, B1); PG8_BAR;
            PG8_LDA(At, 0, 1); PG8_STAGE(PG8_SA(0, 0), a2, voffA);
            PG8_BAR; PG8_WAIT_L(0); PG8_MMA(1, 0, At, B0); PG8_BAR; PG8_SCHED;
            PG8_STAGE(PG8_SB(0, 1), b2 + hstepB, voffB);
            PG8_WAIT_V(6); PG8_BAR; PG8_MMA(1, 1, At, B1); PG8_BAR;
            PG8_LDB(B0, 1, 0); PG8_SCHED; PG8_LDA(At, 1, 0); PG8_STAGE(PG8_SA(0, 1), a2 + hstepA, voffA);
            PG8_WAIT_L(8); PG8_BAR; PG8_WAIT_L(0); PG8_MMA(0, 0, At, B0); PG8_BAR; PG8_SCHED;
            PG8_LDB(B1, 1, 1); PG8_STAGE(PG8_SB(1, 0), b3, voffB);
            PG8_BAR; PG8_WAIT_L(0); PG8_MMA(0, 1, At, B1); PG8_BAR;
            PG8_LDA(At, 1, 1); PG8_STAGE(PG8_SA(1, 0), a3, voffA);
            PG8_BAR; PG8_WAIT_L(0); PG8_MMA(1, 0, At, B0); PG8_BAR; PG8_SCHED;
            PG8_STAGE(PG8_SB(1, 1), b3 + hstepB, voffB);
            PG8_WAIT_V(6); PG8_BAR; PG8_MMA(1, 1, At, B1); PG8_BAR;
            }
        }
        if constexpr (ALIGN_EPI) { if (wr == 0) PG8_BAR; }
        if constexpr (!Epi::AFTER_DRAIN) { E(acc, cur, wr, wc, fr, fq); S.done(cur); }
        if (!has_next) break;
#pragma unroll
        for (int a = 0; a < 2; ++a)
#pragma unroll
            for (int b = 0; b < 2; ++b)
#pragma unroll
                for (int m = 0; m < 4; ++m)
#pragma unroll
                    for (int n = 0; n < 2; ++n) acc[a][b][m][n] = (f32x4){0.f, 0.f, 0.f, 0.f};
        cur = nxt; cA = nA; cB = nB; ++ui;
        if constexpr (ALIGN_EPI) { if (wr == 1) PG8_BAR; }
    }
    PG8_WAIT_V(0);
    if constexpr (!ALIGN_EPI) { if (wr == 0) PG8_BAR; }
    PG8_BAR;
    if constexpr (Epi::AFTER_DRAIN) { E.fused(acc, cur, wr, wc, fr, fq, lds, wid, lane); S.done(cur); }
#undef PG8_SA
#undef PG8_SB
#undef PG8_STAGE
#undef PG8_LDA
#undef PG8_LDB
#undef PG8_MMA
#undef PG8_WAIT_V
#undef PG8_WAIT_L
#undef PG8_BAR
#undef PG8_SCHED
}
}

namespace att {
typedef unsigned short bf16;
typedef __attribute__((ext_vector_type(8))) short bf16x8;
typedef __attribute__((ext_vector_type(4))) short s16x4;
typedef __attribute__((ext_vector_type(16))) float f32x16;
typedef __attribute__((ext_vector_type(4))) unsigned u32x4;
constexpr int KVBLK = 64;
constexpr float SCALE = 0.07216878364870323f;
constexpr float THR = 8.f;
constexpr int SHM_V = 16384, SHM_KN = 16384, SHM_KR = 8192;
constexpr int OFF_V = 0, OFF_KN = 32768, OFF_KR = 65536, OFF_WS = 81920, OFF_QR = 83968, OFF_FLAG = 83968 + 8 * 4096, ATT_LDS = OFF_FLAG + 16;
constexpr int NPIECE = 7;
#define SBAR() __builtin_amdgcn_sched_barrier(0)
__device__ __forceinline__ int crow(int r, int hi) { return (r & 3) + 8 * (r >> 2) + 4 * hi; }
__device__ __forceinline__ unsigned cvtpk(float lo, float hi) { unsigned r; asm volatile("v_cvt_pk_bf16_f32 %0, %1, %2" : "=v"(r) : "v"(lo), "v"(hi)); return r; }
__device__ __forceinline__ bf16x8 ld8(const bf16* p) { return *reinterpret_cast<const bf16x8*>(p); }

__device__ __forceinline__ void partialSM(f32x16& p0, f32x16& p1, float& m_reg, float& mn, float& alpha) {
  constexpr float C = SCALE * 1.4426950408889634f;
  float pmax = p0[0];
#pragma unroll
  for (int r = 1; r < 16; ++r) pmax = fmaxf(pmax, p0[r]);
#pragma unroll
  for (int r = 0; r < 16; ++r) pmax = fmaxf(pmax, p1[r]);
  { auto rr = __builtin_amdgcn_permlane32_swap(__float_as_uint(pmax), __float_as_uint(pmax), false, false);
    pmax = fmaxf(__uint_as_float(rr[0]), __uint_as_float(rr[1])); }
  if (__builtin_expect(__all(pmax - m_reg <= THR / SCALE), 1)) { mn = m_reg; alpha = 1.f; }
  else { mn = fmaxf(m_reg, pmax); alpha = __builtin_amdgcn_exp2f((m_reg - mn) * C); m_reg = mn; }
  float mnC = -mn * C;
#pragma unroll
  for (int r = 0; r < 16; ++r) p0[r] = fmaf(p0[r], C, mnC);
#pragma unroll
  for (int r = 0; r < 16; ++r) p1[r] = fmaf(p1[r], C, mnC);
#pragma unroll
  for (int r = 0; r < 16; ++r) p0[r] = __builtin_amdgcn_exp2f(p0[r]);
}
__device__ __forceinline__ void finishSM(f32x16& p0, f32x16& p1, float alpha, float& l_reg, bf16x8& pa0, bf16x8& pa1, bf16x8& pa2, bf16x8& pa3) {
#pragma unroll
  for (int r = 0; r < 16; ++r) p1[r] = __builtin_amdgcn_exp2f(p1[r]);
  float ps = 0;
#pragma unroll
  for (int r = 0; r < 16; ++r) ps += p0[r];
#pragma unroll
  for (int r = 0; r < 16; ++r) ps += p1[r];
  { auto rr = __builtin_amdgcn_permlane32_swap(__float_as_uint(ps), __float_as_uint(ps), false, false);
    ps = __uint_as_float(rr[0]) + __uint_as_float(rr[1]); }
  l_reg = l_reg * alpha + ps;
#define PK4(P, BASE, OUT) do { unsigned a0 = cvtpk(P[BASE + 0], P[BASE + 1]), a1 = cvtpk(P[BASE + 2], P[BASE + 3]);   \
    unsigned b0 = cvtpk(P[BASE + 4], P[BASE + 5]), b1 = cvtpk(P[BASE + 6], P[BASE + 7]);                              \
    auto r0 = __builtin_amdgcn_permlane32_swap(a0, b0, false, false); auto r1 = __builtin_amdgcn_permlane32_swap(a1, b1, false, false); \
    u32x4 w = {r0[0], r1[0], r0[1], r1[1]}; OUT = *reinterpret_cast<bf16x8*>(&w); } while (0)
  PK4(p0, 0, pa0); PK4(p0, 8, pa1); PK4(p1, 0, pa2); PK4(p1, 8, pa3);
#undef PK4
}
__device__ __forceinline__ void kmask(f32x16& p0, f32x16& p1, int nv, int hi) {
#pragma unroll
  for (int r = 0; r < 16; ++r) { const int k = crow(r, hi); if (k >= nv) p0[r] = -1e30f; if (k + 32 >= nv) p1[r] = -1e30f; }
}
template <int OFF> __device__ __forceinline__ bf16x8 dsr128(int addr) { bf16x8 r; asm volatile("ds_read_b128 %0, %1 offset:%2" : "=&v"(r) : "v"(addr), "i"(OFF) : "memory"); return r; }
#define LGKM_W2(n, x, y) asm volatile("s_waitcnt lgkmcnt(" #n ")" : "+v"(x), "+v"(y) :: "memory")
#define LGKM_W3(n, x, y, z) asm volatile("s_waitcnt lgkmcnt(" #n ")" : "+v"(x), "+v"(y), "+v"(z) :: "memory")
__device__ __forceinline__ void qkt(f32x16& p0, f32x16& p1, const char* Kn, const char* Kr, const char* Qr, const bf16x8* qr, int lane) {
  p0 = f32x16{}; p1 = f32x16{};
  const int kn = (int)(uintptr_t)Kn + (lane & 31) * 16 + (lane >> 5) * 1024, kr = (int)(uintptr_t)Kr + (lane & 31) * 16 + (lane >> 5) * 1024, qa = (int)(uintptr_t)Qr + lane * 16;
  bf16x8 a0, a1, b0, b1, qa_, qb_;
#define MM(K0, K1, QQ) do { p0 = __builtin_amdgcn_mfma_f32_32x32x16_bf16(K0, QQ, p0, 0, 0, 0); p1 = __builtin_amdgcn_mfma_f32_32x32x16_bf16(K1, QQ, p1, 0, 0, 0); } while (0)
  a0 = dsr128<0 * 2048>(kn); a1 = dsr128<0 * 2048 + 512>(kn);
  b0 = dsr128<1 * 2048>(kn); b1 = dsr128<1 * 2048 + 512>(kn); LGKM_W2(2, a0, a1); MM(a0, a1, qr[0]);
  a0 = dsr128<2 * 2048>(kn); a1 = dsr128<2 * 2048 + 512>(kn); LGKM_W2(2, b0, b1); MM(b0, b1, qr[1]);
  b0 = dsr128<3 * 2048>(kn); b1 = dsr128<3 * 2048 + 512>(kn); LGKM_W2(2, a0, a1); MM(a0, a1, qr[2]);
  a0 = dsr128<4 * 2048>(kn); a1 = dsr128<4 * 2048 + 512>(kn); LGKM_W2(2, b0, b1); MM(b0, b1, qr[3]);
  b0 = dsr128<5 * 2048>(kn); b1 = dsr128<5 * 2048 + 512>(kn); LGKM_W2(2, a0, a1); MM(a0, a1, qr[4]);
  a0 = dsr128<6 * 2048>(kn); a1 = dsr128<6 * 2048 + 512>(kn); LGKM_W2(2, b0, b1); MM(b0, b1, qr[5]);
  b0 = dsr128<7 * 2048>(kn); b1 = dsr128<7 * 2048 + 512>(kn); LGKM_W2(2, a0, a1); MM(a0, a1, qr[6]);
  a0 = dsr128<0 * 2048>(kr); a1 = dsr128<0 * 2048 + 512>(kr); qa_ = dsr128<0 * 1024>(qa); LGKM_W2(3, b0, b1); MM(b0, b1, qr[7]);
  b0 = dsr128<1 * 2048>(kr); b1 = dsr128<1 * 2048 + 512>(kr); qb_ = dsr128<1 * 1024>(qa); LGKM_W3(3, a0, a1, qa_); MM(a0, a1, qa_);
  a0 = dsr128<2 * 2048>(kr); a1 = dsr128<2 * 2048 + 512>(kr); qa_ = dsr128<2 * 1024>(qa); LGKM_W3(3, b0, b1, qb_); MM(b0, b1, qb_);
  b0 = dsr128<3 * 2048>(kr); b1 = dsr128<3 * 2048 + 512>(kr); qb_ = dsr128<3 * 1024>(qa); LGKM_W3(3, a0, a1, qa_); MM(a0, a1, qa_);
  LGKM_W3(0, b0, b1, qb_); MM(b0, b1, qb_);
#undef MM
}
__device__ __forceinline__ int v_st(int k, int c) { const int kk = (k & ~0xC) | ((k & 4) << 1) | ((k & 8) >> 1); return ((kk >> 3) * 4 + (c >> 5)) * 512 + ((kk & 7) * 32 + (c & 31)) * 2; }
__device__ __forceinline__ int v_rd_base(int lane) { return ((lane & 3) << 3) | (((lane >> 2) & 3) << 6) | (((lane >> 4) & 1) << 5) | (((lane >> 5) & 1) << 8); }
constexpr int v_rd_off(int d0, int ks, int half) { return d0 * 512 + ks * 4096 + half * 2048; }
template <int OFF> __device__ __forceinline__ s16x4 tr_read(int vb) {
  s16x4 r; asm volatile("ds_read_b64_tr_b16 %0, %1 offset:%2" : "=&v"(r) : "v"(vb), "i"(OFF) : "memory"); return r;
}
struct VF { s16x4 l0, h0, l1, h1, l2, h2, l3, h3; };
template <int D0> __device__ __forceinline__ void pv_rd(VF& f, int vb) {
  f.l0 = tr_read<v_rd_off(D0, 0, 0)>(vb); f.h0 = tr_read<v_rd_off(D0, 0, 1)>(vb); f.l1 = tr_read<v_rd_off(D0, 1, 0)>(vb); f.h1 = tr_read<v_rd_off(D0, 1, 1)>(vb);
  f.l2 = tr_read<v_rd_off(D0, 2, 0)>(vb); f.h2 = tr_read<v_rd_off(D0, 2, 1)>(vb); f.l3 = tr_read<v_rd_off(D0, 3, 0)>(vb); f.h3 = tr_read<v_rd_off(D0, 3, 1)>(vb);
}
#define PV_WAIT(n, f) asm volatile("s_waitcnt lgkmcnt(" #n ")" : "+v"(f.l0), "+v"(f.h0), "+v"(f.l1), "+v"(f.h1), "+v"(f.l2), "+v"(f.h2), "+v"(f.l3), "+v"(f.h3) :: "memory")
__device__ __forceinline__ void pv_mm(f32x16& od, const VF& f, bf16x8 pa0, bf16x8 pa1, bf16x8 pa2, bf16x8 pa3) {
#define PK(L, H) (bf16x8){L[0], L[1], L[2], L[3], H[0], H[1], H[2], H[3]}
  od = __builtin_amdgcn_mfma_f32_32x32x16_bf16(pa0, PK(f.l0, f.h0), od, 0, 0, 0);
  od = __builtin_amdgcn_mfma_f32_32x32x16_bf16(pa1, PK(f.l1, f.h1), od, 0, 0, 0);
  od = __builtin_amdgcn_mfma_f32_32x32x16_bf16(pa2, PK(f.l2, f.h2), od, 0, 0, 0);
  od = __builtin_amdgcn_mfma_f32_32x32x16_bf16(pa3, PK(f.l3, f.h3), od, 0, 0, 0);
#undef PK
}
__device__ __forceinline__ void pv_d0(f32x16* o, int vb, bf16x8 pa0, bf16x8 pa1, bf16x8 pa2, bf16x8 pa3) {
  VF fa, fb;
  pv_rd<0>(fa, vb);
  pv_rd<1>(fb, vb); PV_WAIT(8, fa); pv_mm(o[0], fa, pa0, pa1, pa2, pa3);
  pv_rd<2>(fa, vb); PV_WAIT(8, fb); pv_mm(o[1], fb, pa0, pa1, pa2, pa3);
  pv_rd<3>(fb, vb); PV_WAIT(8, fa); pv_mm(o[2], fa, pa0, pa1, pa2, pa3);
  PV_WAIT(0, fb); pv_mm(o[3], fb, pa0, pa1, pa2, pa3);
}
__device__ __forceinline__ unsigned short f2bf16(float f) { unsigned u = __builtin_bit_cast(unsigned, f); return (unsigned short)((u + 0x7fffu + ((u >> 16) & 1u)) >> 16); }

__device__ __forceinline__ void attn_unit(const bf16* __restrict__ Qg, const bf16* __restrict__ KNg, const bf16* __restrict__ KRg, const bf16* __restrict__ Vg, bf16* __restrict__ AO,
                                          long row0, int L, int h, int q0, char* lds, int tbeg, int NT, float* part, unsigned* cnt, int piece) {
  int tid = threadIdx.x; asm volatile("" : "+v"(tid));
  const int wid = __builtin_amdgcn_readfirstlane(tid >> 6), lane = tid & 63, r32 = lane & 31, hi = lane >> 5;
  char* V_lds = lds + OFF_V; char* KN_lds = lds + OFF_KN; char* KR_lds = lds + OFF_KR;
  float* ws = (float*)(lds + OFF_WS) + wid * 64; float* li_l = ws; float* al_l = ws + 32;
  float m_reg = -1e30f, l_reg = 0; f32x16 o[4] = {}; bf16x8 qr[8]; char* QR_lds = lds + OFF_QR + wid * 4096;
  const bf16* Qw = Qg + (row0 + q0 + wid * 32 + r32) * 768;
#pragma unroll
  for (int d0 = 0; d0 < 8; ++d0) qr[d0] = ld8(Qw + 128 * h + d0 * 16 + hi * 8);
  { const bf16x8 t0 = ld8(Qw + 512 + 32 * h + hi * 8), t1 = ld8(Qw + 512 + 32 * h + 16 + hi * 8), t2 = ld8(Qw + 640 + 32 * h + hi * 8), t3 = ld8(Qw + 640 + 32 * h + 16 + hi * 8);
    *(bf16x8*)(QR_lds + lane * 16) = t0; *(bf16x8*)(QR_lds + lane * 16 + 1024) = t1;
    *(bf16x8*)(QR_lds + lane * 16 + 2048) = t2; *(bf16x8*)(QR_lds + lane * 16 + 3072) = t3; }
  const int sr = tid >> 4, sc = (tid & 15) * 8, vst0 = v_st(sr, sc), vst1 = v_st(32 + sr, sc);
  const int krow = 8 * wid + (lane & 7), kc8 = lane >> 3;
  const int kwoff = (kc8 >> 1) * 2048 + (kc8 & 1) * 1024 + (krow >> 5) * 512 + (krow & 31) * 16;
  const int vb0 = (int)(uintptr_t)V_lds + v_rd_base(lane);
  const bf16* Vh = Vg + row0 * 512 + 128 * h;
  const bf16* Kh = KNg + row0 * 512 + 128 * h;
  const bf16* Rh = KRg + row0 * 64;
  const unsigned kvoff = (unsigned)(sr * 512 + sc), knoff = (unsigned)(krow * 512 + kc8 * 8), kroff = (unsigned)(krow * 64 + kc8 * 8);
  bf16x8 vs0, vs1, ks0, ks1, kr0;
#define KLOAD(k0) do { const bf16* kt_ = Kh + (long)(k0) * 512; const bf16* rt_ = Rh + (long)(k0) * 64; ks0 = ld8(kt_ + knoff); ks1 = ld8(kt_ + 64 + knoff); kr0 = ld8(rt_ + kroff); } while (0)
#define VLOAD(k0) do { const bf16* vt_ = Vh + (long)(k0) * 512; vs0 = ld8(vt_ + kvoff); vs1 = ld8(vt_ + 32 * 512 + kvoff); } while (0)
#define KWRITE(b) do { *(bf16x8*)(KN_lds + (b) * SHM_KN + kwoff) = ks0; *(bf16x8*)(KN_lds + (b) * SHM_KN + 8192 + kwoff) = ks1; *(bf16x8*)(KR_lds + (b) * SHM_KR + kwoff) = kr0; } while (0)
#define VWRITE(b) do { *(bf16x8*)(V_lds + (b) * SHM_V + vst0) = vs0; *(bf16x8*)(V_lds + (b) * SHM_V + vst1) = vs1; } while (0)
#define SWAIT() asm volatile("s_waitcnt vmcnt(0)" ::: "memory")
#define RESC(a) do { if (__any((a) < 1.f)) { if (hi == 0) al_l[r32] = (a); asm volatile("s_waitcnt lgkmcnt(0)" ::: "memory"); \
    _Pragma("unroll") for (int d = 0; d < 4; ++d) _Pragma("unroll") for (int r = 0; r < 16; ++r) o[d][r] *= al_l[crow(r, hi)]; } } while (0)
  f32x16 pA0, pA1, pB0, pB1; float mnA, mnB, alA, alB; bf16x8 pa0, pa1, pa2, pa3;
  const int NTt = (L + KVBLK - 1) / KVBLK, nv_last = L - (NTt - 1) * KVBLK;
  KLOAD(tbeg * KVBLK); VLOAD(tbeg * KVBLK); SWAIT(); KWRITE(0); VWRITE(0); __syncthreads();
  qkt(pA0, pA1, KN_lds, KR_lds, QR_lds, qr, lane);
  KLOAD((tbeg + 1) * KVBLK);
  partialSM(pA0, pA1, m_reg, mnA, alA);
  SWAIT(); KWRITE(1); __syncthreads();
  for (int j = 1; j + 1 < NT; j += 2) {
    SBAR(); qkt(pB0, pB1, KN_lds + SHM_KN, KR_lds + SHM_KR, QR_lds, qr, lane);
    finishSM(pA0, pA1, alA, l_reg, pa0, pa1, pa2, pa3); SBAR();
    KLOAD((tbeg + j + 1) * KVBLK); VLOAD((tbeg + j) * KVBLK); SBAR();
    pv_d0(o, vb0, pa0, pa1, pa2, pa3); partialSM(pB0, pB1, m_reg, mnB, alB);
    RESC(alB);
    SWAIT(); KWRITE(0); VWRITE(1); __syncthreads();
    SBAR(); qkt(pA0, pA1, KN_lds, KR_lds, QR_lds, qr, lane);
    finishSM(pB0, pB1, alB, l_reg, pa0, pa1, pa2, pa3); SBAR();
    const bool more = (j + 2 < NT);
    if (more) KLOAD((tbeg + j + 2) * KVBLK);
    VLOAD((tbeg + j + 1) * KVBLK); SBAR();
    pv_d0(o, vb0 + SHM_V, pa0, pa1, pa2, pa3);
    if (tbeg + j + 1 == NTt - 1) kmask(pA0, pA1, nv_last, hi);
    partialSM(pA0, pA1, m_reg, mnA, alA);
    RESC(alA);
    SWAIT(); if (more) KWRITE(1); VWRITE(0); __syncthreads();
  }
  finishSM(pA0, pA1, alA, l_reg, pa0, pa1, pa2, pa3); SBAR();
  pv_d0(o, vb0, pa0, pa1, pa2, pa3);
  int lane_e = lane, wid_e = wid, q0_e = q0, h_e = h, L_e = L; long row0_e = row0; char* lds_e = lds;
  asm volatile("" : "+v"(lane_e)); asm volatile("" : "+s"(wid_e), "+s"(q0_e), "+s"(h_e), "+s"(L_e), "+s"(row0_e), "+s"(lds_e));
  if (part != nullptr) {
    __syncthreads();
    if (wid_e == 0) { const int r32e = lane_e & 31, hie = lane_e >> 5;
#pragma unroll
      for (int r = 0; r < 8; ++r) { const int orow = crow(r, hie);
#pragma unroll
        for (int d0 = 0; d0 < 4; ++d0) part[(piece * 16 + orow) * 132 + d0 * 32 + r32e] = o[d0][r]; }
      if (lane_e < 16) { part[(piece * 16 + lane_e) * 132 + 128] = m_reg; part[(piece * 16 + lane_e) * 132 + 129] = l_reg; } }
    __threadfence();
    __syncthreads();
    __attribute__((address_space(3))) unsigned* flag = (__attribute__((address_space(3))) unsigned*)(lds_e + OFF_FLAG);
    if (wid_e == 0 && lane_e == 0) { const unsigned old = __hip_atomic_fetch_add(cnt, 1u, __ATOMIC_RELAXED, __HIP_MEMORY_SCOPE_AGENT); *flag = old; }
    __syncthreads();
    const bool last = (*(volatile __attribute__((address_space(3))) unsigned*)flag == (unsigned)(NPIECE - 1));
    if (last) {
      __threadfence();
      constexpr float C = SCALE * 1.4426950408889634f;
      const int t = wid_e * 64 + lane_e, row = t >> 5, c4 = (t & 31) * 4;
      float mmax = -3.0e38f;
#pragma unroll
      for (int i = 0; i < NPIECE; ++i) mmax = fmaxf(mmax, (*(part + (i * 16 + row) * 132 + 128)));
      float lsum = 0.f; float a0 = 0.f, a1 = 0.f, a2 = 0.f, a3 = 0.f;
#pragma unroll
      for (int i = 0; i < NPIECE; ++i) { const float* pr = part + (i * 16 + row) * 132;
        const float w = __builtin_amdgcn_exp2f(((*(pr + 128)) - mmax) * C); lsum += (*(pr + 129)) * w;
        a0 += (*(pr + c4)) * w; a1 += (*(pr + c4 + 1)) * w; a2 += (*(pr + c4 + 2)) * w; a3 += (*(pr + c4 + 3)) * w; }
      const float rl = 1.0f / lsum;
      const unsigned w0 = (unsigned)f2bf16(a0 * rl) | ((unsigned)f2bf16(a1 * rl) << 16), w1 = (unsigned)f2bf16(a2 * rl) | ((unsigned)f2bf16(a3 * rl) << 16);
      unsigned* dst = (unsigned*)(AO + (row0_e + q0_e + row) * 1024 + 128 * h_e + c4);
      dst[0] = w0; dst[1] = w1;
    }
    __syncthreads();
    return;
  }
  if (hi == 0) li_l[r32] = l_reg; asm volatile("s_waitcnt lgkmcnt(0)" ::: "memory");
  float rli[16];
#pragma unroll
  for (int r = 0; r < 16; ++r) rli[r] = __builtin_amdgcn_rcpf(li_l[crow(r, hi)]);
  __syncthreads();
  __attribute__((address_space(3))) unsigned short* stg = (__attribute__((address_space(3))) unsigned short*)(lds_e + wid_e * 8192);
  { const int r32e = lane_e & 31, hie = lane_e >> 5;
#pragma unroll
  for (int r = 0; r < 16; ++r) { const int orow = crow(r, hie);
#pragma unroll
    for (int d0 = 0; d0 < 4; ++d0) stg[orow * 128 + d0 * 32 + r32e] = f2bf16(o[d0][r] * rli[r]); } }
  asm volatile("s_waitcnt lgkmcnt(0)" ::: "memory");
  const int qw = q0_e + wid_e * 32;
  bf16* AOw = AO + (row0_e + qw) * 1024 + 128 * h_e + (lane_e & 15) * 8;
#pragma unroll
  for (int i = 0; i < 8; ++i) { const int row = i * 4 + (lane_e >> 4); const u32x4 v = *(const __attribute__((address_space(3))) u32x4*)(stg + row * 128 + (lane_e & 15) * 8);
    if (qw + row < L_e) *(u32x4*)(AOw + (long)row * 1024) = v; }
  asm volatile("s_waitcnt lgkmcnt(0)" ::: "memory");
  __syncthreads();
#undef KLOAD
#undef VLOAD
#undef KWRITE
#undef VWRITE
#undef SWAIT
#undef RESC
}
#undef SBAR
}


#define LAS __attribute__((address_space(3)))
typedef unsigned short bf16;
typedef unsigned v4u __attribute__((ext_vector_type(4)));
typedef unsigned v2u __attribute__((ext_vector_type(2)));
typedef float f32x4 __attribute__((ext_vector_type(4)));
constexpr int NWAVES = 8;
constexpr int LDS_BYTES = 147456;
constexpr int NPH = 1 + 8 * NLAYER;
constexpr int N_LAUNCHES = MK_N_LAUNCHES;

constexpr size_t MiB = 1u << 20;
constexpr size_t SZ_WIN = (size_t)NZ * 1024 * 2, SZ_WQ = 768 * 384 * 2, SZ_WKV = 1024 * 256 * 2, SZ_WO = 1024 * 1024 * 2, SZ_WGU = (size_t)5632 * 1024 * 2, SZ_WD = (size_t)1024 * 2816 * 2;
constexpr size_t OFFW_IN = 0, OFFW_Q = OFFW_IN + SZ_WIN, OFFW_KV = OFFW_Q + SZ_WQ, OFFW_O = OFFW_KV + SZ_WKV, OFFW_GU = OFFW_O + SZ_WO, OFFW_D = OFFW_GU + SZ_WGU, SZ_WLAYER = OFFW_D + SZ_WD;
constexpr size_t WS_CTL = 0, WS_BAR = 16384, WS_PART = 65536;
constexpr int LDS_BARST = 147456 - 64;
constexpr size_t WS_W = 1 * MiB, WS_ROPE = 50 * MiB, WS_SSQ = 55 * MiB, WS_SSQX = 63 * MiB + 512 * 1024, WS_X = 64 * MiB;
constexpr size_t WS_GB = 193 * MiB, WS_U = 257 * MiB + 512 * 1024, WS_ZQ = 322 * MiB, WS_AO = 322 * MiB, WS_F = 193 * MiB, WS_ACT1 = 322 * MiB;
constexpr int ACT_SPLIT = 138;
constexpr size_t WS_END = 512 * MiB;
constexpr size_t D_Q = 0, D_KN = (size_t)MP * 768 * 2, D_V = D_KN + (size_t)MP * 512 * 2, D_KR = D_V + (size_t)MP * 512 * 2, D_MIX = 0, D_ACT2 = 0;
static_assert(WS_W + 2 * SZ_WLAYER <= WS_ROPE && WS_ROPE + (size_t)L_S * 64 * 4 <= WS_SSQ && WS_SSQ + (size_t)MP * 32 * 4 <= WS_SSQX && WS_SSQX + (size_t)MP * 4 <= WS_X, "ws fixed region");
static_assert(WS_X + (size_t)MP * 1024 * 2 <= WS_GB && WS_GB + (size_t)MP * 512 * 2 <= WS_U && WS_U + (size_t)MP * 512 * 2 <= WS_ZQ && WS_ZQ + (size_t)MP * 768 * 2 <= WS_END, "ws map 1");
static_assert(WS_AO + (size_t)MP * 1024 * 2 <= WS_END && WS_F + (size_t)MP * 1024 * 2 <= WS_ACT1 && WS_ACT1 + (size_t)ACT_SPLIT * 256 * 2816 * 2 <= WS_END, "ws map 2");
static_assert(D_KR + (size_t)MP * 64 * 2 <= (size_t)256 * MiB && (size_t)(MP / 256 - ACT_SPLIT) * 256 * 2816 * 2 <= (size_t)256 * MiB && (size_t)MP * 1024 * 2 <= (size_t)256 * MiB, "d_out scratch map");

__device__ const double INVF[32] = {1.0, 0.7498942093324559, 0.5623413251903491, 0.4216965034285822, 0.31622776601683794, 0.23713737056616552, 0.1778279410038923, 0.1333521432163324, 0.1, 0.07498942093324558, 0.05623413251903491, 0.042169650342858224, 0.03162277660168379, 0.023713737056616554, 0.01778279410038923, 0.01333521432163324, 0.01, 0.007498942093324558, 0.005623413251903491, 0.004216965034285823, 0.0031622776601683794, 0.0023713737056616554, 0.0017782794100389228, 0.001333521432163324, 0.001, 0.0007498942093324559, 0.0005623413251903491, 0.00042169650342858224, 0.00031622776601683794, 0.00023713737056616554, 0.00017782794100389227, 0.0001333521432163324};

#define LDS_WAIT() asm volatile("s_waitcnt lgkmcnt(0)" ::: "memory")
__device__ __forceinline__ unsigned f2bf(float f) { unsigned u = __builtin_bit_cast(unsigned, f); return (u + 0x7fffu + ((u >> 16) & 1u)) >> 16; }
__device__ __forceinline__ unsigned pk2(float lo, float hi) { return f2bf(lo) | (f2bf(hi) << 16); }
__device__ __forceinline__ float bflo(unsigned w) { return __builtin_bit_cast(float, w << 16); }
__device__ __forceinline__ float bfhi(unsigned w) { return __builtin_bit_cast(float, w & 0xffff0000u); }
__device__ __forceinline__ float wave_sum(float v) {
#pragma unroll
    for (int o = 1; o < 64; o <<= 1) v += __shfl_xor(v, o);
    return v;
}
__device__ __forceinline__ float half_sum32(float v) {
#pragma unroll
    for (int o = 1; o < 32; o <<= 1) v += __shfl_xor(v, o);
    return v;
}

struct Args { const float* in[17]; float* out; unsigned char* ws; int ph_lo, ph_hi; };

__device__ __forceinline__ void p0_transpose_item(const float* W, int Nsrc, int K, int sc0, const float* g, bf16* WT, int dr0, int k0, LAS float* scr, int lane) {
    if (sc0 >= 0) {
#pragma unroll 8
        for (int i = 0; i < 32; ++i) { const int kk = 2 * i + (lane >> 5); const float gv = g ? g[k0 + kk] : 1.0f; scr[kk * 33 + (lane & 31)] = W[(size_t)(k0 + kk) * Nsrc + sc0 + (lane & 31)] * gv; }
    } else {
#pragma unroll 8
        for (int i = 0; i < 32; ++i) { const int kk = 2 * i + (lane >> 5); scr[kk * 33 + (lane & 31)] = 0.0f; }
    }
    LDS_WAIT(); asm volatile("" ::: "memory");
    const int c = lane & 7;
#pragma unroll
    for (int j = 0; j < 4; ++j) { const int n = (lane >> 3) + 8 * j; const LAS float* s = scr + (8 * c) * 33 + n;
        v4u o; o.x = pk2(s[0 * 33], s[1 * 33]); o.y = pk2(s[2 * 33], s[3 * 33]); o.z = pk2(s[4 * 33], s[5 * 33]); o.w = pk2(s[6 * 33], s[7 * 33]);
        *(v4u*)(WT + (size_t)(dr0 + n) * K + k0 + 8 * c) = o; }
    LDS_WAIT(); asm volatile("" ::: "memory");
}

__device__ __forceinline__ void p0_prologue(const Args& a, LAS unsigned char* lds, int gw, int NGW, int wave, int lane) {
    LAS float* scr = (LAS float*)(lds + wave * 16384);
    unsigned char* ws = a.ws;
    if (gw == 0 && lane < 2 * 8) ((unsigned*)(ws + WS_CTL))[lane * 64] = 0u;
    if (gw < NWAVES) { for (int i = gw * 64 + lane; i < 3456; i += NWAVES * 64) ((unsigned*)(ws + WS_BAR))[i] = 0u; }
    constexpr int I0 = 16 * 72, I1 = 6 * 24, I2 = 4 * 32, I3 = 16 * 32, I4 = 16 * 176, I5 = 44 * 32, IL = I0 + I1 + I2 + I3 + I4 + I5;
    for (int it = gw; it < NLAYER * IL; it += NGW) {
        const int l = it / IL; int r = it % IL;
        bf16* wl = (bf16*)(ws + WS_W + (size_t)l * SZ_WLAYER);
        if (r < I0) {
            const int kb = r / 72, nb = r % 72, n0 = nb * 32; int sc;
            if (n0 < 704) sc = n0; else if (n0 < 768) sc = -1; else if (n0 < 1280) sc = n0 - 64;
            else { const int t = (n0 - 1280) >> 8, w = (n0 - 1280) & 255; sc = (w < 128) ? 1216 + 128 * t + w : 1728 + 128 * t + (w - 128); }
            p0_transpose_item(a.in[4] + (size_t)l * 1024 * 2240, 2240, 1024, sc, a.in[3] + l * 1024, (bf16*)((unsigned char*)wl + OFFW_IN), n0, kb * 64, scr, lane); continue; }
        r -= I0;
        if (r < I1) {
            const int kb = r / 24, nb = r % 24, n0 = nb * 32; int sc;
            if (n0 < 512) sc = 192 * (n0 >> 7) + (n0 & 127); else if (n0 < 640) sc = 192 * ((n0 - 512) >> 5) + 128; else sc = 192 * ((n0 - 640) >> 5) + 160;
            p0_transpose_item(a.in[6] + (size_t)l * 384 * 768, 768, 384, sc, a.in[5] + l * 384, (bf16*)((unsigned char*)wl + OFFW_Q), n0, kb * 64, scr, lane); continue; }
        r -= I1;
        if (r < I2) {
            const int kb = r / 32, nb = r % 32, n0 = nb * 32; int sc;
            if (n0 < 512) sc = 256 * (n0 >> 7) + (n0 & 127); else sc = 256 * ((n0 - 512) >> 7) + 128 + ((n0 - 512) & 127);
            p0_transpose_item(a.in[8] + (size_t)l * 256 * 1024, 1024, 256, sc, a.in[7] + l * 256, (bf16*)((unsigned char*)wl + OFFW_KV), n0, kb * 64, scr, lane); continue; }
        r -= I2;
        if (r < I3) {
            const int kb = r / 32, nb = r % 32, n0 = nb * 32;
            p0_transpose_item(a.in[10] + (size_t)l * 1024 * 1024, 1024, 1024, n0, nullptr, (bf16*)((unsigned char*)wl + OFFW_O), n0, kb * 64, scr, lane); continue; }
        r -= I3;
        if (r < I4) {
            const int kb = r / 176, nb = r % 176, n0 = nb * 32; const int t = n0 >> 8, w = n0 & 255;
            const float* src = (w < 128) ? a.in[13] : a.in[14]; const int sc = 128 * t + (w & 127);
            p0_transpose_item(src + (size_t)l * 1024 * 2816, 2816, 1024, sc, a.in[12] + l * 1024, (bf16*)((unsigned char*)wl + OFFW_GU), n0, kb * 64, scr, lane); continue; }
        r -= I4;
        {
            const int kb = r / 32, nb = r % 32, n0 = nb * 32;
            p0_transpose_item(a.in[15] + (size_t)l * 2816 * 1024, 1024, 2816, n0, nullptr, (bf16*)((unsigned char*)wl + OFFW_D), n0, kb * 64, scr, lane); }
    }
    {
        float* rope = (float*)(ws + WS_ROPE);
        const int gt = gw * 64 + lane, NGT = NGW * 64;
        for (int idx = gt; idx < L_S * 32; idx += NGT) {
            const int pos = idx >> 5, i = idx & 31;
            const double ang = (double)pos * INVF[i];
            const double TWO_PI = 6.283185307179586476925286766559;
            const double kq = __builtin_rint(ang * (1.0 / TWO_PI));
            const double rr = __builtin_fma(-kq, TWO_PI, ang);
            const double x = rr * 0.125, x2 = x * x;
            double sn = x * (1.0 + x2 * (-1.0 / 6.0 + x2 * (1.0 / 120.0 + x2 * (-1.0 / 5040.0 + x2 * (1.0 / 362880.0 + x2 * (-1.0 / 39916800.0))))));
            double cs = 1.0 + x2 * (-0.5 + x2 * (1.0 / 24.0 + x2 * (-1.0 / 720.0 + x2 * (1.0 / 40320.0 + x2 * (-1.0 / 3628800.0 + x2 * (1.0 / 479001600.0))))));
#pragma unroll
            for (int d = 0; d < 3; ++d) { const double s2 = 2.0 * sn * cs, c2 = cs * cs - sn * sn; sn = s2; cs = c2; }
            rope[(size_t)pos * 64 + i] = (float)cs; rope[(size_t)pos * 64 + 32 + i] = (float)sn;
        }
    }
    {
        bf16* X = (bf16*)(ws + WS_X); float* ssqX = (float*)(ws + WS_SSQX);
        for (int r = gw; r < MP; r += NGW) {
            v2u* o8 = (v2u*)(X + (size_t)r * 1024) + lane;
            if (r >= M_REAL) {
#pragma unroll
                for (int j = 0; j < 4; ++j) o8[64 * j] = (v2u){0u, 0u};
                if (lane == 0) ssqX[r] = 0.0f;
                continue;
            }
            const float* src;
            if (r < ROWS_P) { const int s = r / L_P, pos = r - s * L_P; src = (pos < 16) ? a.in[2] + pos * 1024 : a.in[0] + ((size_t)s * 2048 + (pos - 16)) * 1024; }
            else { const int q = r - ROWS_P, s = q / L_S, pos = q - s * L_S; src = (pos < 16) ? a.in[2] + pos * 1024 : a.in[1] + ((size_t)s * 16384 + (pos - 16)) * 1024; }
            const f32x4* xr = (const f32x4*)src + lane;
            f32x4 v[4]; float s2 = 0.f;
#pragma unroll
            for (int j = 0; j < 4; ++j) { v[j] = xr[64 * j]; s2 += (v[j].x * v[j].x + v[j].y * v[j].y) + (v[j].z * v[j].z + v[j].w * v[j].w); }
            s2 = wave_sum(s2);
#pragma unroll
            for (int j = 0; j < 4; ++j) o8[64 * j] = (v2u){pk2(v[j].x, v[j].y), pk2(v[j].z, v[j].w)};
            if (lane == 0) ssqX[r] = s2;
        }
    }
}

__device__ __forceinline__ void kr_pass(const bf16* ZQ, const float* rope, bf16* KR, int gw, int NGW, int lane) {
    const int i = lane & 31;
    for (int r = gw; r < MP; r += NGW) {
        const int pos = pg8::row_pos(r);
        const bf16* z = ZQ + (size_t)r * 768 + 640;
        const float x1 = bflo((unsigned)z[i]), x2 = bflo((unsigned)z[32 + i]);
        const float c = rope[(size_t)pos * 64 + i], s = rope[(size_t)pos * 64 + 32 + i];
        const float y = (lane < 32) ? (x1 * c - x2 * s) : (x2 * c + x1 * s);
        KR[(size_t)r * 64 + lane] = (bf16)f2bf(y);
    }
}
__device__ __forceinline__ void conv_pass(const bf16* GB, const bf16* U, const float* cw  , bf16* AO, int gw, int NGW, int lane) {
    const int c0 = lane * 8;
    f32x4 w[3][2];
#pragma unroll
    for (int k = 0; k < 3; ++k) { w[k][0] = *(const f32x4*)(cw + k * 512 + c0); w[k][1] = *(const f32x4*)(cw + k * 512 + c0 + 4); }
    for (int r = gw; r < MP; r += NGW) {
        v4u* dst = (v4u*)(AO + (size_t)r * 1024 + 512 + c0);
        if (r >= M_REAL) { *dst = (v4u){0u, 0u, 0u, 0u}; *(v4u*)(AO + (size_t)r * 1024 + c0) = (v4u){0u, 0u, 0u, 0u}; continue; }
        int pos, L;
        if (r < ROWS_P) { pos = r % L_P; L = L_P; } else { pos = (r - ROWS_P) % L_S; L = L_S; }
        const v4u g = *(const v4u*)(GB + (size_t)r * 512 + c0);
        const v4u u1 = *(const v4u*)(U + (size_t)r * 512 + c0);
        v4u u0 = (v4u){0u, 0u, 0u, 0u}, u2 = (v4u){0u, 0u, 0u, 0u};
        if (pos > 0) u0 = *(const v4u*)(U + (size_t)(r - 1) * 512 + c0);
        if (pos < L - 1) u2 = *(const v4u*)(U + (size_t)(r + 1) * 512 + c0);
        v4u o;
#pragma unroll
        for (int q = 0; q < 4; ++q) {
            const int h = q >> 1, e = (q & 1) * 2;
            const float lo = bflo(g[q]) * (w[0][h][e] * bflo(u0[q]) + w[1][h][e] * bflo(u1[q]) + w[2][h][e] * bflo(u2[q]));
            const float hi = bfhi(g[q]) * (w[0][h][e + 1] * bfhi(u0[q]) + w[1][h][e + 1] * bfhi(u1[q]) + w[2][h][e + 1] * bfhi(u2[q]));
            o[q] = pk2(lo, hi);
        }
        *dst = o;
    }
}
__device__ __forceinline__ void nr_pass(bf16* X, const bf16* Y, const float* SSQ, float* ssqX, const float* g, float* out  , int gw, int NGW, int lane) {
    f32x4 gv[4];
#pragma unroll
    for (int j = 0; j < 4; ++j) gv[j] = *((const f32x4*)g + lane + 64 * j);
    for (int r = gw; r < M_REAL; r += NGW) {
        const float part = SSQ[(size_t)r * 32 + (lane & 31)];
        const float s = rsqrtf(half_sum32(part) * (1.0f / 1024.0f) + EPS);
        v2u* x8 = (v2u*)(X + (size_t)r * 1024) + lane; const v2u* y8 = (const v2u*)(Y + (size_t)r * 1024) + lane;
        f32x4 v[4]; float s2 = 0.f;
#pragma unroll
        for (int j = 0; j < 4; ++j) { const v2u xv = x8[64 * j], yv = y8[64 * j];
            v[j].x = bflo(xv.x) + bflo(yv.x) * s * gv[j].x; v[j].y = bfhi(xv.x) + bfhi(yv.x) * s * gv[j].y;
            v[j].z = bflo(xv.y) + bflo(yv.y) * s * gv[j].z; v[j].w = bfhi(xv.y) + bfhi(yv.y) * s * gv[j].w;
            s2 += (v[j].x * v[j].x + v[j].y * v[j].y) + (v[j].z * v[j].z + v[j].w * v[j].w); }
        if (out == nullptr) {
            s2 = wave_sum(s2);
#pragma unroll
            for (int j = 0; j < 4; ++j) x8[64 * j] = (v2u){pk2(v[j].x, v[j].y), pk2(v[j].z, v[j].w)};
            if (lane == 0) ssqX[r] = s2;
        } else {
            int pos; size_t orow;
            if (r < ROWS_P) { const int sq = r / L_P; pos = r - sq * L_P; orow = (size_t)sq * 2048 + (pos - 16); }
            else { const int q = r - ROWS_P, sq = q / L_S; pos = q - sq * L_S; orow = (size_t)NSEQ_P * 2048 + (size_t)sq * 16384 + (pos - 16); }
            if (pos >= 16) { f32x4* o = (f32x4*)(out + orow * 1024) + lane;
#pragma unroll
                for (int j = 0; j < 4; ++j) o[64 * j] = v[j]; }
        }
    }
}

constexpr int NU_S = 512, NU_PC = 56, NU_P = 576, NU = NU_S + NU_PC + NU_P;
__device__ __forceinline__ int attn_next(int i, int G, int bx) {
    if (G == 256) {
        const int vcu = (bx & 7) * 32 + (bx >> 3), x = vcu >> 5, c = vcu & 31;
        if (i == 0) return 64 * x + c;
        if (i == 1) return 64 * x + 32 + c;
        const int e = c + 32 * (i - 2);
        if (e >= 79) return -1;
        if (e < 15) return NU_S + NU_PC + 72 * x + e;
        if (e < 22) return NU_S + 7 * x + (e - 15);
        return NU_S + NU_PC + 72 * x + (e - 7);
    }
    const int id = i * G + bx; return (id < NU) ? id : -1;
}

#define XB_TMO      128
#define XB_XCNT(j)  (256  + 64 * (j))
#define XB_XSUB(j)  (1280 + 64 * (j))
#define XB_XGEN(j)  (2304 + 64 * (j))
#define XB_TOP      3328
#define XB_TOPGEN   3392
#define XCD_BAR_WORDS 3456
#define XB_SPIN_CAP (1u << 18)

__device__ __forceinline__ unsigned xb_ld(unsigned* p)              { return __hip_atomic_load(p, __ATOMIC_RELAXED, __HIP_MEMORY_SCOPE_AGENT); }
__device__ __forceinline__ unsigned xb_add(unsigned* p, unsigned v) { return __hip_atomic_fetch_add(p, v, __ATOMIC_RELAXED, __HIP_MEMORY_SCOPE_AGENT); }
__device__ __forceinline__ unsigned xb_xcc_id() { return (unsigned)__builtin_amdgcn_s_getreg((3 << 11) | 20) & 0xFu; }
#define XB_SPIN(cond, bar) do { unsigned _sp = 0; while (cond) { __builtin_amdgcn_s_sleep(1); \
    if ((++_sp & 255u) == 0u) { if (xb_ld(&(bar)[XB_TMO])) break; if (_sp > XB_SPIN_CAP) { atomicAdd(&(bar)[XB_TMO], 1u); break; } } } } while (0)

struct XcdBarrier {
    unsigned* bar; unsigned x;
    volatile LAS unsigned* st;
};

__device__ __forceinline__ XcdBarrier xcd_barrier_post(unsigned* bar, volatile LAS unsigned* st) {
    XcdBarrier b; b.bar = bar; b.x = xb_xcc_id(); b.st = st;
    if (threadIdx.x == 0) (void)xb_add(&bar[XB_XCNT(b.x)], 1u);
    return b;
}
__device__ __forceinline__ void xcd_barrier_complete(unsigned* bar, unsigned x, unsigned& nloc, unsigned& nx) {
    const unsigned G = gridDim.x * gridDim.y * gridDim.z;
    unsigned sum, cnt, mine, sp = 0u;
    for (;;) {
        sum = 0u; cnt = 0u; mine = 0u;
#pragma unroll
        for (unsigned j = 0; j < 16; ++j) { const unsigned c = xb_ld(&bar[XB_XCNT(j)]); sum += c; cnt += (c > 0u) ? 1u : 0u; mine = (j == x) ? c : mine; }
        if (sum == G) break;
        __builtin_amdgcn_s_sleep(1);
        if ((++sp & 255u) == 0u) { if (xb_ld(&bar[XB_TMO])) break; if (sp > XB_SPIN_CAP) { atomicAdd(&bar[XB_TMO], 1u); break; } }
    }
    nloc = mine > 0u ? mine : 1u; nx = cnt > 0u ? cnt : 1u;
}

__device__ __forceinline__ void xcd_barrier(const XcdBarrier& b) {
    asm volatile("s_waitcnt vmcnt(0)" ::: "memory");
    __syncthreads();
    if (threadIdx.x == 0) {
        unsigned* bar = b.bar;
        __builtin_amdgcn_s_waitcnt(0);
        unsigned nloc = b.st[0], nx = b.st[1];
        if (nloc == 0u) { xcd_barrier_complete(bar, b.x, nloc, nx); b.st[0] = nloc; b.st[1] = nx; }
        const unsigned old = xb_add(&bar[XB_XSUB(b.x)], 1u);
        const unsigned gen = old / nloc;
        if (old + 1u == (gen + 1u) * nloc) {
            __builtin_amdgcn_fence(__ATOMIC_RELEASE, "agent");
            asm volatile("s_waitcnt vmcnt(0)" ::: "memory");
            const unsigned og = xb_add(&bar[XB_TOP], 1u);
            const unsigned tg = og / nx;
            if (og + 1u == (tg + 1u) * nx) xb_add(&bar[XB_TOPGEN], 1u);
            else XB_SPIN(xb_ld(&bar[XB_TOPGEN]) == tg, bar);
            __builtin_amdgcn_fence(__ATOMIC_ACQUIRE, "agent");
            xb_add(&bar[XB_XGEN(b.x)], 1u);
            asm volatile("s_waitcnt vmcnt(0)" ::: "memory");
        } else {
            XB_SPIN(xb_ld(&bar[XB_XGEN(b.x)]) == gen, bar);
            __builtin_amdgcn_fence(__ATOMIC_ACQUIRE, "agent");
            asm volatile("s_waitcnt vmcnt(0)" ::: "memory");
        }
    }
    __syncthreads();
}

__device__ __forceinline__ int attn_next_last(int i, int G, int bx) {
    if (G == 256) {
        const int vcu = (bx & 7) * 32 + (bx >> 3), x = vcu >> 5, c = vcu & 31;
        if (i == 0) return 64 * x + c;
        if (i == 1) return 64 * x + 32 + c;
        if (i < 4) return 512 + 64 * x + c + 32 * (i - 2);
        return -1;
    }
    const int id = i * G + bx; return (id < 1024) ? id : -1;
}

#define GAS __attribute__((address_space(1)))
#define LAUNDER_BASES() GAS unsigned char* wsg_ = (GAS unsigned char*)a.ws; GAS unsigned char* dsg_ = (GAS unsigned char*)a.out; asm volatile("" : "+s"(wsg_), "+s"(dsg_)); \
    unsigned char* ws = (unsigned char*)wsg_; unsigned char* dsc = (unsigned char*)dsg_;     \
    int lane = threadIdx.x & 63, wave = __builtin_amdgcn_readfirstlane(threadIdx.x >> 6), G = gridDim.x, bx = blockIdx.x; \
    asm volatile("" : "+v"(lane)); asm volatile("" : "+s"(wave), "+s"(G), "+s"(bx)); \
    const int gw = bx * NWAVES + wave, NGW = G * NWAVES; (void)gw; (void)NGW; (void)lane; (void)dsc
#define P_X ((bf16*)(ws + WS_X))
#define P_GB ((bf16*)(ws + WS_GB))
#define P_U ((bf16*)(ws + WS_U))
#define P_ZQ ((bf16*)(ws + WS_ZQ))
#define P_AO ((bf16*)(ws + WS_AO))
#define P_F ((bf16*)(ws + WS_F))
#define P_ACT1 ((bf16*)(ws + WS_ACT1))
#define P_ACT2 ((bf16*)(dsc + D_ACT2))
#define P_Q ((bf16*)(dsc + D_Q))
#define P_KN ((bf16*)(dsc + D_KN))
#define P_V ((bf16*)(dsc + D_V))
#define P_KR ((bf16*)(dsc + D_KR))
#define P_MIX ((bf16*)(dsc + D_MIX))
#define P_SSQ ((float*)(ws + WS_SSQ))
#define P_SSQX ((float*)(ws + WS_SSQX))
#define P_ROPE ((const float*)(ws + WS_ROPE))
#define PH_IN(p) (lo <= (p) && (p) < hi && ((PHM >> ((p) == 0 ? 0 : (((p) - 1) & 7) + 1)) & 1))
#define PH_SYNC(p) do { if (lo <= (p) && (p) + 1 < hi) xcd_barrier(bar); } while (0)

template <int LYR>
__device__ __forceinline__ void layer_phases(const Args& a, const XcdBarrier& bar, unsigned char* lds, int lo, int hi) {
    LAS unsigned char* ldsl = (LAS unsigned char*)lds;
    constexpr int P0 = 1 + 8 * LYR;
    constexpr size_t WOFF = WS_W + (size_t)LYR * SZ_WLAYER;
    if (PH_IN(P0 + 0)) {
        LAUNDER_BASES();
        pg8::Gemm g{P_X, P_X, 1 << 30, (const bf16*)(ws + WOFF + OFFW_IN), MP, NZ, 1024, 1024}; pg8::StaticOrder S; S.init(MP, NZ, G, bx);
        pg8::EpiZ E{P_ZQ, P_GB, P_U, P_SSQ, P_SSQX};
        pg8::gemm_phase<pg8::EpiZ, pg8::StaticOrder, true, true>(ldsl, g, S, E);
    }
    PH_SYNC(P0 + 0);
    if (PH_IN(P0 + 1)) {
        { LAUNDER_BASES();
          pg8::Gemm g{P_ZQ, P_ZQ, 1 << 30, (const bf16*)(ws + WOFF + OFFW_Q), MP, 768, 384, 768}; pg8::StaticOrder S; S.init(MP, 768, G, bx);
          pg8::EpiQ E{P_Q, P_SSQ, P_ROPE};
          pg8::gemm_phase<pg8::EpiQ, pg8::StaticOrder, true, true>(ldsl, g, S, E); }
        { LAUNDER_BASES();
          pg8::Gemm g{P_ZQ + 384, P_ZQ + 384, 1 << 30, (const bf16*)(ws + WOFF + OFFW_KV), MP, 1024, 256, 768}; pg8::StaticOrder S; S.init(MP, 1024, G, (bx + 128) % G);
          pg8::EpiKV E{P_KN, P_V, P_SSQ};
          pg8::gemm_phase<pg8::EpiKV, pg8::StaticOrder, true, true>(ldsl, g, S, E); }
        { LAUNDER_BASES(); kr_pass(P_ZQ, P_ROPE, P_KR, gw, NGW, lane); }
    }
    PH_SYNC(P0 + 1);
    if (PH_IN(P0 + 2)) {
        { LAUNDER_BASES(); conv_pass(P_GB, P_U, a.in[9] + (size_t)LYR * 3 * 512, P_AO, gw, NGW, lane); }
        __syncthreads();
        { LAUNDER_BASES();
          for (int i = 0;; ++i) {
            constexpr bool LASTL = (LYR == NLAYER - 1);
            const int id = LASTL ? attn_next_last(i, G, bx) : attn_next(i, G, bx); if (id < 0) break;
            long row0; int L, h, qb, tbeg = 0, nt; float* part = nullptr; unsigned* cnt = nullptr; int piece = 0;
            if (LASTL) {
                if (id < 512) { const int pair = id >> 6; qb = id & 63; h = pair & 3; row0 = ROWS_P + (long)(pair >> 2) * L_S; L = L_S; nt = 257; }
                else { const int e = id - 512, pair = e >> 3; qb = e & 7; h = pair & 3; row0 = (long)(pair >> 2) * L_P; L = L_P; nt = 33; }
            } else if (id < NU_S) { const int pair = id >> 6; qb = id & 63; h = pair & 3; row0 = ROWS_P + (long)(pair >> 2) * L_S; L = L_S; nt = 257; }
            else if (id < NU_S + NU_PC) { const int k = id - NU_S, pair = k / 7; piece = k - pair * 7; qb = 64; h = pair & 3; row0 = ROWS_P + (long)(pair >> 2) * L_S; L = L_S;
                tbeg = 37 * piece; nt = (piece == 6) ? 35 : 37; part = (float*)(ws + WS_PART) + (size_t)pair * att::NPIECE * 16 * 132; cnt = (unsigned*)(ws + WS_CTL) + (LYR * 8 + pair) * 64; }
            else { const int e = id - NU_S - NU_PC, pair = e / 9; qb = e - pair * 9; h = pair & 3; row0 = (long)(pair >> 2) * L_P; L = L_P; nt = 33; }
            att::attn_unit(P_Q, P_KN, P_KR, P_V, P_AO, row0, L, h, qb * 256 + (LASTL ? 16 : 0), (char*)lds, tbeg, nt, part, cnt, piece);
          } }
    }
    PH_SYNC(P0 + 2);
    if (PH_IN(P0 + 3)) {
        LAUNDER_BASES();
        pg8::Gemm g{P_AO, P_AO, 1 << 30, (const bf16*)(ws + WOFF + OFFW_O), MP, 1024, 1024, 1024}; pg8::StaticOrder S; S.init(MP, 1024, G, bx);
        pg8::EpiMix E{P_MIX, P_SSQ};
        pg8::gemm_phase<pg8::EpiMix, pg8::StaticOrder, true, true>(ldsl, g, S, E);
    }
    PH_SYNC(P0 + 3);
    if (PH_IN(P0 + 4)) {
        LAUNDER_BASES(); nr_pass(P_X, P_MIX, P_SSQ, P_SSQX, a.in[11] + LYR * 1024, nullptr, gw, NGW, lane);
    }
    PH_SYNC(P0 + 4);
    if (PH_IN(P0 + 5)) {
        LAUNDER_BASES();
        pg8::Gemm g{P_X, P_X, 1 << 30, (const bf16*)(ws + WOFF + OFFW_GU), MP, 5632, 1024, 1024}; pg8::StaticOrder S; S.init(MP, 5632, G, bx);
        pg8::EpiAct E{P_ACT1, P_ACT2, ACT_SPLIT, P_SSQX};
        pg8::gemm_phase<pg8::EpiAct, pg8::StaticOrder, true, true>(ldsl, g, S, E);
    }
    PH_SYNC(P0 + 5);
    if (PH_IN(P0 + 6)) {
        LAUNDER_BASES();
        pg8::Gemm g{P_ACT1, P_ACT2, ACT_SPLIT, (const bf16*)(ws + WOFF + OFFW_D), MP, 1024, 2816, 2816}; pg8::StaticOrder S; S.init(MP, 1024, G, bx);
        pg8::EpiMix E{P_F, P_SSQ};
        pg8::gemm_phase<pg8::EpiMix, pg8::StaticOrder, true, true>(ldsl, g, S, E);
    }
    PH_SYNC(P0 + 6);
    if (PH_IN(P0 + 7)) {
        LAUNDER_BASES(); nr_pass(P_X, P_F, P_SSQ, P_SSQX, a.in[16] + LYR * 1024, (LYR == NLAYER - 1) ? a.out : nullptr, gw, NGW, lane);
    }
    PH_SYNC(P0 + 7);
}

__global__ void __launch_bounds__(NWAVES * 64, 2) mega_fwd(Args a) {
    extern __shared__ __attribute__((aligned(16))) unsigned char lds[];
    cg::grid_group grid = cg::this_grid();
    const int lo = a.ph_lo, hi = a.ph_hi;
    volatile LAS unsigned* barst = (volatile LAS unsigned*)((LAS unsigned char*)lds + LDS_BARST);
    if (threadIdx.x == 0) { barst[0] = 0u; barst[1] = 0u; }
    __syncthreads();
    if (PH_IN(0)) { LAUNDER_BASES(); p0_prologue(a, (LAS unsigned char*)lds, gw, NGW, wave, lane); }
    XcdBarrier bar; bar.bar = nullptr; bar.x = 0; bar.st = barst;
    if (lo <= 0 && 1 < hi) {
        grid.sync();
        bar = xcd_barrier_post((unsigned*)(a.ws + WS_BAR), barst);
    }
    layer_phases<0>(a, bar, lds, lo, hi);
    layer_phases<1>(a, bar, lds, lo, hi);
}

extern "C" void kernel_launch(void* const* d_in, const int* in_sizes, int n_in, void* d_out, int out_size, void* d_ws, size_t ws_size, hipStream_t stream) {
    static int grid = 0;
    if (grid == 0) {
        if (n_in != 17 || in_sizes[0] != 16 * 2048 * 1024 || in_sizes[1] != 2 * 16384 * 1024 || out_size != 65536 * 1024 || ws_size < WS_END) {
            fprintf(stderr, "kernel_launch: unexpected shapes / workspace (n_in %d, ws %zu, need %zu); nothing launched\n", n_in, ws_size, (size_t)WS_END); grid = -1; return; }
        int dev = 0, cus = 0, per_cu = 0;
        if (hipGetDevice(&dev) != hipSuccess || hipDeviceGetAttribute(&cus, hipDeviceAttributeMultiprocessorCount, dev) != hipSuccess) { grid = -1; return; }
        if (hipFuncSetAttribute((const void*)mega_fwd, hipFuncAttributeMaxDynamicSharedMemorySize, LDS_BYTES) != hipSuccess) { fprintf(stderr, "kernel_launch: hipFuncSetAttribute failed\n"); grid = -1; return; }
        if (hipOccupancyMaxActiveBlocksPerMultiprocessor(&per_cu, (const void*)mega_fwd, NWAVES * 64, LDS_BYTES) != hipSuccess || per_cu < 1) { fprintf(stderr, "kernel_launch: occupancy query failed (%d)\n", per_cu); per_cu = 1; }
        (void)hipGetLastError();
        grid = cus * per_cu;
    }
    if (grid < 0) return;
    Args a{};
    for (int i = 0; i < 17; ++i) a.in[i] = (const float*)d_in[i];
    a.out = (float*)d_out; a.ws = (unsigned char*)d_ws;
    if (N_LAUNCHES == 1) {
        a.ph_lo = 0; a.ph_hi = NPH;
        void* args[] = {&a};
        hipError_t e = hipLaunchCooperativeKernel((void*)mega_fwd, dim3(grid), dim3(NWAVES * 64), args, LDS_BYTES, stream);
        if (e != hipSuccess) fprintf(stderr, "kernel_launch: cooperative launch failed: %s (grid %d)\n", hipGetErrorString(e), grid);
    } else {
        for (int ph = 0; ph < NPH; ++ph) {
            a.ph_lo = ph; a.ph_hi = ph + 1;
            hipLaunchKernelGGL(mega_fwd, dim3(grid), dim3(NWAVES * 64), LDS_BYTES, stream, a);
        }
    }
}
```

```cpp
#include <hip/hip_runtime.h>
#include <hip/hip_cooperative_groups.h>
#include <cstdio>
#include <cstdint>
namespace cg = cooperative_groups;

#ifndef PHM
#define PHM 511
#endif
#ifndef MK_N_LAUNCHES
#define MK_N_LAUNCHES 1
#endif

constexpr int DM = 1024, DFF = 2816, NLAYER = 2;
constexpr int L_P = 2064, L_S = 16400, NSEQ_P = 16, NSEQ_S = 2;
constexpr int ROWS_P = NSEQ_P * L_P;
constexpr int M_REAL = ROWS_P + NSEQ_S * L_S;
constexpr int MP = 66048;
constexpr int NZ = 2304;
constexpr float EPS = 1e-6f;
static_assert(MP % 256 == 0 && MP >= M_REAL, "row padding");

namespace pg8 {
#define PG8_LAS __attribute__((address_space(3)))
typedef unsigned short bf16_t;
typedef short bf16x8 __attribute__((ext_vector_type(8)));
typedef float f32x4 __attribute__((ext_vector_type(4)));
typedef unsigned u32x4 __attribute__((ext_vector_type(4)));
constexpr int BM = 256, BK = 64, HALF = 128, HTB = HALF * BK * 2  , STAGE_BYTES = 8 * HTB, NXCD = 8, WGM = 8;

__host__ __device__ __forceinline__ int lds_byte(int r, int c) { const int st = (r >> 4) * 2 + (c >> 5), rr = r & 15, cc = c & 31, ob = rr * 64 + cc * 2; return st * 1024 + (ob ^ (((ob >> 9) & 1) << 5)); }
__host__ __device__ __forceinline__ void stage_rc(int b, int& R, int& C) { const int st = b / 1024, sb = b % 1024, swz = sb ^ (((sb >> 9) & 1) << 5); R = (st >> 1) * 16 + swz / 64; C = (st & 1) * 32 + (swz % 64) / 2; }
__host__ __device__ __forceinline__ int perm32(int rho) { const int n = rho >> 4, i = rho & 15; return 8 * (i >> 2) + 4 * n + (i & 3); }

struct Unit { int pm, pn; };
struct Gemm { const bf16_t* A; const bf16_t* A2; int pm_split; const bf16_t* Bt; int M, N, K, lda; };

struct StaticOrder {
    int nM, nN, nwg, G, c;
    __host__ __device__ void init(int M, int N, int G_, int c_) { nM = M / BM; nN = N / BM; nwg = nM * nN; G = G_; c = c_; }
    __host__ __device__ bool next(int i, Unit& u) const {
        const long L = (long)i * G + c; if (L >= nwg) return false;
        int wgid = (int)L; { const int q = nwg / NXCD, r = nwg % NXCD, xcd = wgid % NXCD, off = wgid / NXCD; wgid = (xcd < r ? xcd * (q + 1) : r * (q + 1) + (xcd - r) * q) + off; }
        const int nig = WGM * nN, gid = wgid / nig, fm = gid * WGM, gsz = (nM - fm) < WGM ? (nM - fm) : WGM;
        u.pm = fm + ((wgid % nig) % gsz); u.pn = (wgid % nig) / gsz; return true;
    }
    __device__ __forceinline__ void a_ready(const Unit&) const {}
    __device__ __forceinline__ void done(const Unit&) const {}
};


__device__ __forceinline__ unsigned cvt_pk_bf16(float lo, float hi) { unsigned r; asm volatile("v_cvt_pk_bf16_f32 %0, %1, %2" : "=v"(r) : "v"(lo), "v"(hi)); return r; }
__device__ __forceinline__ void st8(bf16_t* p, f32x4 a, f32x4 b) { u32x4 w; w.x = cvt_pk_bf16(a[0], a[1]); w.y = cvt_pk_bf16(a[2], a[3]); w.z = cvt_pk_bf16(b[0], b[1]); w.w = cvt_pk_bf16(b[2], b[3]); *(u32x4*)p = w; }
__device__ __forceinline__ float ssq4(f32x4 a) { return (a[0] * a[0] + a[1] * a[1]) + (a[2] * a[2] + a[3] * a[3]); }
__device__ __forceinline__ float red_fq(float p) { p += __shfl_xor(p, 16); p += __shfl_xor(p, 32); return p; }
__device__ __forceinline__ int row_pos(int r) {
    int pos;
    if (r < ROWS_P) pos = r % L_P; else { pos = (r - ROWS_P) % L_S; }
    return pos;
}

struct EpiZ {
    static constexpr bool PERM = true, AFTER_DRAIN = false;
    bf16_t* ZQ; bf16_t* GB; bf16_t* U; float* SSQ; const float* ssqX;
    __device__ __forceinline__ void operator()(const f32x4 (&acc)[2][2][4][2], const Unit& u, int wr, int wc, int fr, int fq) const {
        asm volatile("" : "+v"(fr), "+v"(fq)); asm volatile("" : "+s"(wr), "+s"(wc));
        const int row0 = u.pm * BM + wr * 64 + fr, pn = u.pn, cw = wc * 32 + fq * 8;
#pragma unroll
        for (int ai = 0; ai < 2; ++ai)
#pragma unroll
            for (int m = 0; m < 4; ++m) {
                const int row = row0 + ai * HALF + m * 16;
                const float s = rsqrtf(ssqX[row] * (1.0f / 1024.0f) + EPS);
                const f32x4 a0 = acc[ai][0][m][0] * s, a1 = acc[ai][0][m][1] * s, b0 = acc[ai][1][m][0] * s, b1 = acc[ai][1][m][1] * s;
                if (pn < 3) {
                    bf16_t* p = ZQ + (size_t)row * 768 + pn * 256 + cw;
                    st8(p, a0, a1); st8(p + HALF, b0, b1);
                    const float pa = red_fq(ssq4(a0) + ssq4(a1)), pb = red_fq(ssq4(b0) + ssq4(b1));
                    if (fq == 0) { SSQ[(size_t)row * 32 + pn * 8 + wc] = pa; SSQ[(size_t)row * 32 + pn * 8 + 4 + wc] = pb; }
                } else if (pn < 5) {
                    bf16_t* p = GB + (size_t)row * 512 + (pn - 3) * 256 + cw;
                    st8(p, a0, a1); st8(p + HALF, b0, b1);
                } else {
                    bf16_t* p = U + (size_t)row * 512 + (pn - 5) * 128 + cw;
                    st8(p, a0 * b0, a1 * b1);
                }
                asm volatile("" ::: "memory");
            }
    }
};
struct EpiQ {
    static constexpr bool PERM = true, AFTER_DRAIN = false;
    bf16_t* Q; const float* SSQ; const float* ROPE;
    __device__ __forceinline__ void operator()(const f32x4 (&acc)[2][2][4][2], const Unit& u, int wr, int wc, int fr, int fq) const {
        asm volatile("" : "+v"(fr), "+v"(fq)); asm volatile("" : "+s"(wr), "+s"(wc));
        const int row0 = u.pm * BM + wr * 64 + fr, pn = u.pn, cw = wc * 32 + fq * 8;
#pragma unroll
        for (int ai = 0; ai < 2; ++ai)
#pragma unroll
            for (int m = 0; m < 4; ++m) {
                const int row = row0 + ai * HALF + m * 16;
                const f32x4* sp = (const f32x4*)(SSQ + (size_t)row * 32);
                const f32x4 s0 = sp[0], s1 = sp[1], s2 = sp[2];
                const float ss = ((s0[0] + s0[1]) + (s0[2] + s0[3])) + ((s1[0] + s1[1]) + (s1[2] + s1[3])) + ((s2[0] + s2[1]) + (s2[2] + s2[3]));
                const float s = rsqrtf(ss * (1.0f / 384.0f) + EPS);
                const f32x4 a0 = acc[ai][0][m][0] * s, a1 = acc[ai][0][m][1] * s, b0 = acc[ai][1][m][0] * s, b1 = acc[ai][1][m][1] * s;
                bf16_t* qrow = Q + (size_t)row * 768;
                if (pn < 2) { st8(qrow + pn * 256 + cw, a0, a1); st8(qrow + pn * 256 + HALF + cw, b0, b1); }
                else {
                    const int pos = row_pos(row);
                    const f32x4* cp = (const f32x4*)(ROPE + (size_t)pos * 64 + fq * 8);
                    const f32x4 c0 = cp[0], c1 = cp[1], n0 = cp[8], n1 = cp[9];
                    st8(qrow + 512 + cw, a0 * c0 - b0 * n0, a1 * c1 - b1 * n1);
                    st8(qrow + 640 + cw, b0 * c0 + a0 * n0, b1 * c1 + a1 * n1);
                }
                asm volatile("" ::: "memory");
            }
    }
};
struct EpiKV {
    static constexpr bool PERM = true, AFTER_DRAIN = false;
    bf16_t* KN; bf16_t* V; const float* SSQ;
    __device__ __forceinline__ void operator()(const f32x4 (&acc)[2][2][4][2], const Unit& u, int wr, int wc, int fr, int fq) const {
        asm volatile("" : "+v"(fr), "+v"(fq)); asm volatile("" : "+s"(wr), "+s"(wc));
        const int row0 = u.pm * BM + wr * 64 + fr, pn = u.pn, cw = wc * 32 + fq * 8;
        bf16_t* base = (pn < 2) ? KN + pn * 256 : V + (pn - 2) * 256;
#pragma unroll
        for (int ai = 0; ai < 2; ++ai)
#pragma unroll
            for (int m = 0; m < 4; ++m) {
                const int row = row0 + ai * HALF + m * 16;
                const f32x4* sp = (const f32x4*)(SSQ + (size_t)row * 32);
                const f32x4 s0 = sp[3], s1 = sp[4];
                const float ss = ((s0[0] + s0[1]) + (s0[2] + s0[3])) + ((s1[0] + s1[1]) + (s1[2] + s1[3]));
                const float s = rsqrtf(ss * (1.0f / 256.0f) + EPS);
                bf16_t* p = base + (size_t)row * 512 + cw;
                st8(p, acc[ai][0][m][0] * s, acc[ai][0][m][1] * s); st8(p + HALF, acc[ai][1][m][0] * s, acc[ai][1][m][1] * s);
                asm volatile("" ::: "memory");
            }
    }
};
struct EpiMix {
    static constexpr bool PERM = true, AFTER_DRAIN = false;
    bf16_t* OUT; float* SSQ;
    __device__ __forceinline__ void operator()(const f32x4 (&acc)[2][2][4][2], const Unit& u, int wr, int wc, int fr, int fq) const {
        asm volatile("" : "+v"(fr), "+v"(fq)); asm volatile("" : "+s"(wr), "+s"(wc));
        const int row0 = u.pm * BM + wr * 64 + fr, pn = u.pn, cw = wc * 32 + fq * 8;
#pragma unroll
        for (int ai = 0; ai < 2; ++ai)
#pragma unroll
            for (int m = 0; m < 4; ++m) {
                const int row = row0 + ai * HALF + m * 16;
                const f32x4 a0 = acc[ai][0][m][0], a1 = acc[ai][0][m][1], b0 = acc[ai][1][m][0], b1 = acc[ai][1][m][1];
                bf16_t* p = OUT + (size_t)row * 1024 + pn * 256 + cw;
                st8(p, a0, a1); st8(p + HALF, b0, b1);
                const float pa = red_fq(ssq4(a0) + ssq4(a1)), pb = red_fq(ssq4(b0) + ssq4(b1));
                if (fq == 0) { SSQ[(size_t)row * 32 + pn * 8 + wc] = pa; SSQ[(size_t)row * 32 + pn * 8 + 4 + wc] = pb; }
            }
    }
};
struct EpiAct {
    static constexpr bool PERM = true, AFTER_DRAIN = false;
    bf16_t* ACT1; bf16_t* ACT2; int pm_split; const float* ssqX;
    __device__ __forceinline__ void operator()(const f32x4 (&acc)[2][2][4][2], const Unit& u, int wr, int wc, int fr, int fq) const {
        asm volatile("" : "+v"(fr), "+v"(fq)); asm volatile("" : "+s"(wr), "+s"(wc));
        const int rl0 = wr * 64 + fr, pn = u.pn, cw = wc * 32 + fq * 8;
        bf16_t* base = (u.pm < pm_split) ? ACT1 + (size_t)u.pm * BM * 2816 : ACT2 + (size_t)(u.pm - pm_split) * BM * 2816;
#pragma unroll
        for (int ai = 0; ai < 2; ++ai)
#pragma unroll
            for (int m = 0; m < 4; ++m) {
                const int rl = rl0 + ai * HALF + m * 16;
                const float s = rsqrtf(ssqX[u.pm * BM + rl] * (1.0f / 1024.0f) + EPS);
                f32x4 o[2];
#pragma unroll
                for (int n = 0; n < 2; ++n) {
                    const f32x4 g = acc[ai][0][m][n] * s, up = acc[ai][1][m][n] * s;
#pragma unroll
                    for (int j = 0; j < 4; ++j) { const float e = __builtin_amdgcn_exp2f(g[j] * -1.4426950408889634f); o[n][j] = g[j] * __builtin_amdgcn_rcpf(1.0f + e) * up[j]; }
                }
                st8(base + (size_t)rl * 2816 + pn * 128 + cw, o[0], o[1]);
                asm volatile("" ::: "memory");
            }
    }
};

template <class Epi, class Sched, bool ALIGN_EPI = false, bool SP2 = false>
__device__ __forceinline__ void gemm_phase(PG8_LAS unsigned char* lds, const Gemm g, const Sched& S, const Epi& E) {
    int tid = threadIdx.x; asm volatile("" : "+v"(tid));
    const int wid = __builtin_amdgcn_readfirstlane(tid >> 6), lane = tid & 63, wr = wid >> 2, wc = wid & 3, fr = lane & 15, fq = lane >> 4;
    int K = g.K; asm volatile("" : "+s"(K));
    const int nt = K / BK;
    unsigned voffA[2], voffB[2];
#pragma unroll
    for (int i = 0; i < 2; ++i) { int R, C; stage_rc(tid * 16 + i * 8192, R, C); const int Rb = Epi::PERM ? ((R & ~31) + perm32(R & 31)) : R;
        voffA[i] = (unsigned)(R * g.lda + C) * 2u; voffB[i] = (unsigned)(Rb * K + C) * 2u; }
    const size_t kstep = (size_t)(BK * 2);
    const size_t hstepA = (size_t)HALF * g.lda * 2, hstepB = (size_t)HALF * K * 2;
    const size_t tstepA = 2 * hstepA, tstepB = 2 * hstepB;
    const unsigned ldsw = (unsigned)wid * 1024u;
    const int aoff = lds_byte(wr * 64 + fr, fq * 8), boff = lds_byte(wc * 32 + fr, fq * 8);
#define PG8_SA(b, h) (((b) * 2 + (h)) * HTB)
#define PG8_SB(b, h) ((4 + (b) * 2 + (h)) * HTB)
#define PG8_STAGE(bufoff, gbase, voff) do { _Pragma("unroll") for (int _i = 0; _i < 2; ++_i) \
        __builtin_amdgcn_global_load_lds((const unsigned*)((const char*)(gbase) + (voff)[_i]), (PG8_LAS unsigned*)(lds + (bufoff) + ldsw + _i * 8192), 16, 0, 0); } while (0)
#define PG8_LDA(dst, b, h) do { _Pragma("unroll") for (int m = 0; m < 4; ++m) _Pragma("unroll") for (int k = 0; k < 2; ++k) dst[m][k] = *(const PG8_LAS bf16x8*)(lds + PG8_SA(b, h) + aoff + m * 2048 + k * 1024); } while (0)
#define PG8_LDB(dst, b, h) do { _Pragma("unroll") for (int n = 0; n < 2; ++n) _Pragma("unroll") for (int k = 0; k < 2; ++k) dst[n][k] = *(const PG8_LAS bf16x8*)(lds + PG8_SB(b, h) + boff + n * 2048 + k * 1024); } while (0)
#define PG8_MMA(ai, bj, At, Bt) do { __builtin_amdgcn_s_setprio(1); _Pragma("unroll") for (int m = 0; m < 4; ++m) _Pragma("unroll") for (int n = 0; n < 2; ++n) _Pragma("unroll") for (int k = 0; k < 2; ++k) \
        acc[ai][bj][m][n] = __builtin_amdgcn_mfma_f32_16x16x32_bf16(Bt[n][k], At[m][k], acc[ai][bj][m][n], 0, 0, 0); __builtin_amdgcn_s_setprio(0); } while (0)
#define PG8_WAIT_V(n) asm volatile("s_waitcnt vmcnt(" #n ")" ::: "memory")
#define PG8_WAIT_L(n) asm volatile("s_waitcnt lgkmcnt(" #n ")" ::: "memory")
#define PG8_BAR __builtin_amdgcn_s_barrier()
#define PG8_SCHED __builtin_amdgcn_sched_barrier(0)
    Unit cur, nxt; int ui = 0;
    if (!S.next(0, cur)) return;
    f32x4 acc[2][2][4][2];
#pragma unroll
    for (int a = 0; a < 2; ++a)
#pragma unroll
        for (int b = 0; b < 2; ++b)
#pragma unroll
            for (int m = 0; m < 4; ++m)
#pragma unroll
                for (int n = 0; n < 2; ++n) acc[a][b][m][n] = (f32x4){0.f, 0.f, 0.f, 0.f};
    bf16x8 At[4][2], B0[2][2], B1[2][2];
    const char* cA = (cur.pm < g.pm_split) ? (const char*)g.A + (size_t)cur.pm * tstepA : (const char*)g.A2 + (size_t)(cur.pm - g.pm_split) * tstepA; const char* cB = (const char*)g.Bt + (size_t)cur.pn * tstepB;
    S.a_ready(cur);
    if constexpr (SP2) {
        PG8_STAGE(PG8_SB(0, 0), cB, voffB); PG8_STAGE(PG8_SB(0, 1), cB + hstepB, voffB); PG8_STAGE(PG8_SA(0, 0), cA, voffA); PG8_STAGE(PG8_SA(0, 1), cA + hstepA, voffA);
        if (wr == 1) PG8_BAR;
        PG8_WAIT_V(2); PG8_BAR;
        PG8_STAGE(PG8_SB(1, 0), cB + kstep, voffB); PG8_STAGE(PG8_SA(1, 0), cA + kstep, voffA); PG8_STAGE(PG8_SB(1, 1), cB + hstepB + kstep, voffB);
        PG8_WAIT_V(6); PG8_BAR;
    } else {
        PG8_STAGE(PG8_SB(0, 0), cB, voffB); PG8_STAGE(PG8_SA(0, 0), cA, voffA); PG8_STAGE(PG8_SB(0, 1), cB + hstepB, voffB); PG8_STAGE(PG8_SA(0, 1), cA + hstepA, voffA);
        if (wr == 1) PG8_BAR;
        PG8_WAIT_V(4); PG8_BAR;
        PG8_STAGE(PG8_SB(1, 0), cB + kstep, voffB); PG8_STAGE(PG8_SA(1, 0), cA + kstep, voffA); PG8_STAGE(PG8_SB(1, 1), cB + hstepB + kstep, voffB);
        PG8_WAIT_V(6); PG8_BAR;
    }
    for (;;) {
        const bool has_next = S.next(ui + 1, nxt);
        const char* nA = has_next ? ((nxt.pm < g.pm_split) ? (const char*)g.A + (size_t)nxt.pm * tstepA : (const char*)g.A2 + (size_t)(nxt.pm - g.pm_split) * tstepA) : cA; const char* nB = has_next ? (const char*)g.Bt + (size_t)nxt.pn * tstepB : cB;
        for (int t = 0; t < nt; t += 2) {
            const bool last = (t == nt - 2);
            const char* a1 = cA + (size_t)(t + 1) * kstep;
            const char* a2 = last ? nA : cA + (size_t)(t + 2) * kstep; const char* b2 = last ? nB : cB + (size_t)(t + 2) * kstep;
            const char* a3 = a2 + kstep; const char* b3 = b2 + kstep;
            if (last && has_next) S.a_ready(nxt);
            if constexpr (SP2) {
            PG8_LDB(B0, 0, 0); PG8_LDB(B1, 0, 1); PG8_SCHED; PG8_LDA(At, 0, 0); PG8_STAGE(PG8_SA(1, 1), a1 + hstepA, voffA);
            PG8_WAIT_V(8); PG8_WAIT_L(0); PG8_BAR; PG8_MMA(0, 0, At, B0); PG8_MMA(0, 1, At, B1); PG8_BAR; PG8_SCHED;
            PG8_LDA(At, 0, 1); PG8_STAGE(PG8_SB(0, 0), b2, voffB); PG8_STAGE(PG8_SB(0, 1), b2 + hstepB, voffB); PG8_STAGE(PG8_SA(0, 0), a2, voffA);
            PG8_WAIT_V(8); PG8_WAIT_L(0); PG8_BAR; PG8_MMA(1, 0, At, B0); PG8_MMA(1, 1, At, B1); PG8_BAR; PG8_SCHED;
            PG8_LDB(B0, 1, 0); PG8_LDB(B1, 1, 1); PG8_SCHED; PG8_LDA(At, 1, 0); PG8_STAGE(PG8_SA(0, 1), a2 + hstepA, voffA);
            PG8_WAIT_V(8); PG8_WAIT_L(0); PG8_BAR; PG8_MMA(0, 0, At, B0); PG8_MMA(0, 1, At, B1); PG8_BAR; PG8_SCHED;
            PG8_LDA(At, 1, 1); PG8_STAGE(PG8_SB(1, 0), b3, voffB); PG8_STAGE(PG8_SB(1, 1), b3 + hstepB, voffB); PG8_STAGE(PG8_SA(1, 0), a3, voffA);
            PG8_WAIT_V(8); PG8_WAIT_L(0); PG8_BAR; PG8_MMA(1, 0, At, B0); PG8_MMA(1, 1, At, B1); PG8_BAR; PG8_SCHED;
            } else {
            PG8_LDB(B0, 0, 0); PG8_SCHED; PG8_LDA(At, 0, 0); PG8_STAGE(PG8_SA(1, 1), a1 + hstepA, voffA);
            PG8_WAIT_L(8); PG8_BAR; PG8_WAIT_L(0); PG8_MMA(0, 0, At, B0); PG8_BAR; PG8_SCHED;
            PG8_LDB(B1, 0, 1); PG8_STAGE(PG8_SB(0, 0), b2, voffB);
            PG8_BAR; PG8_WAIT_L(0); PG8_MMA(0, 1, At, B1); PG8_BAR;
            PG8_LDA(At, 0, 1); PG8_STAGE(PG8_SA(0, 0), a2, voffA);
            PG8_BAR; PG8_WAIT_L(0); PG8_MMA(1, 0, At, B0); PG8_BAR; PG8_SCHED;
            PG8_STAGE(PG8_SB(0, 1), b2 + hstepB, voffB);
            PG8_WAIT_V(6); PG8_BAR; PG8_MMA(1, 1, At, B1); PG8_BAR;
            PG8_LDB(B0, 1, 0); PG8_SCHED; PG8_LDA(At, 1, 0); PG8_STAGE(PG8_SA(0, 1), a2 + hstepA, voffA);
            PG8_WAIT_L(8); PG8_BAR; PG8_WAIT_L(0); PG8_MMA(0, 0, At, B0); PG8_BAR; PG8_SCHED;
            PG8_LDB(B1, 1, 1); PG8_STAGE(PG8_SB(1, 0), b3, voffB);
            PG8_BAR; PG8_WAIT_L(0); PG8_MMA(0, 1, At, B1); PG8_BAR;
            PG8_LDA(At, 1, 1); PG8_STAGE(PG8_SA(1, 0), a3, voffA);
            PG8_BAR; PG8_WAIT_L(0); PG8_MMA(1, 0, At, B0); PG8_BAR; PG8_SCHED;
            PG8_STAGE(PG8_SB(1, 1), b3 + hstepB, voffB);
            PG8_WAIT_V(6); PG8_BAR; PG8_MMA(1, 1, At, B1); PG8_BAR;
            }
        }
        if constexpr (ALIGN_EPI) { if (wr == 0) PG8_BAR; }
        if constexpr (!Epi::AFTER_DRAIN) { E(acc, cur, wr, wc, fr, fq); S.done(cur); }
        if (!has_next) break;
#pragma unroll
        for (int a = 0; a < 2; ++a)
#pragma unroll
            for (int b = 0; b < 2; ++b)
#pragma unroll
                for (int m = 0; m < 4; ++m)
#pragma unroll
                    for (int n = 0; n < 2; ++n) acc[a][b][m][n] = (f32x4){0.f, 0.f, 0.f, 0.f};
        cur = nxt; cA = nA; cB = nB; ++ui;
        if constexpr (ALIGN_EPI) { if (wr == 1) PG8_BAR; }
    }
    PG8_WAIT_V(0);
    if constexpr (!ALIGN_EPI) { if (wr == 0) PG8_BAR; }
    PG8_BAR;
    if constexpr (Epi::AFTER_DRAIN) { E.fused(acc, cur, wr, wc, fr, fq, lds, wid, lane); S.done(cur); }
#undef PG8_SA
#undef PG8_SB
#undef PG8_STAGE
#undef PG8_LDA
#undef PG8_LDB
#undef PG8_MMA
#undef PG8_WAIT_V
#undef PG8_WAIT_L
#undef PG8_BAR
#undef PG8_SCHED
}
}

namespace att {
typedef unsigned short bf16;
typedef __attribute__((ext_vector_type(8))) short bf16x8;
typedef __attribute__((ext_vector_type(4))) short s16x4;
typedef __attribute__((ext_vector_type(16))) float f32x16;
typedef __attribute__((ext_vector_type(4))) unsigned u32x4;
constexpr int KVBLK = 64;
constexpr float SCALE = 0.07216878364870323f;
constexpr float THR = 8.f;
constexpr int SHM_V = 16384, SHM_KN = 16384, SHM_KR = 8192;
constexpr int OFF_V = 0, OFF_KN = 32768, OFF_KR = 65536, OFF_WS = 81920, OFF_QR = 83968, OFF_FLAG = 83968 + 8 * 4096, ATT_LDS = OFF_FLAG + 16;
constexpr int NPIECE = 7;
#define SBAR() __builtin_amdgcn_sched_barrier(0)
__device__ __forceinline__ int crow(int r, int hi) { return (r & 3) + 8 * (r >> 2) + 4 * hi; }
__device__ __forceinline__ unsigned cvtpk(float lo, float hi) { unsigned r; asm volatile("v_cvt_pk_bf16_f32 %0, %1, %2" : "=v"(r) : "v"(lo), "v"(hi)); return r; }
__device__ __forceinline__ bf16x8 ld8(const bf16* p) { return *reinterpret_cast<const bf16x8*>(p); }

__device__ __forceinline__ void partialSM(f32x16& p0, f32x16& p1, float& m_reg, float& mn, float& alpha) {
  constexpr float C = SCALE * 1.4426950408889634f;
  float pmax = p0[0];
#pragma unroll
  for (int r = 1; r < 16; ++r) pmax = fmaxf(pmax, p0[r]);
#pragma unroll
  for (int r = 0; r < 16; ++r) pmax = fmaxf(pmax, p1[r]);
  { auto rr = __builtin_amdgcn_permlane32_swap(__float_as_uint(pmax), __float_as_uint(pmax), false, false);
    pmax = fmaxf(__uint_as_float(rr[0]), __uint_as_float(rr[1])); }
  if (__builtin_expect(__all(pmax - m_reg <= THR / SCALE), 1)) { mn = m_reg; alpha = 1.f; }
  else { mn = fmaxf(m_reg, pmax); alpha = __builtin_amdgcn_exp2f((m_reg - mn) * C); m_reg = mn; }
  float mnC = -mn * C;
#pragma unroll
  for (int r = 0; r < 16; ++r) p0[r] = fmaf(p0[r], C, mnC);
#pragma unroll
  for (int r = 0; r < 16; ++r) p1[r] = fmaf(p1[r], C, mnC);
#pragma unroll
  for (int r = 0; r < 16; ++r) p0[r] = __builtin_amdgcn_exp2f(p0[r]);
}
__device__ __forceinline__ void finishSM(f32x16& p0, f32x16& p1, float alpha, float& l_reg, bf16x8& pa0, bf16x8& pa1, bf16x8& pa2, bf16x8& pa3) {
#pragma unroll
  for (int r = 0; r < 16; ++r) p1[r] = __builtin_amdgcn_exp2f(p1[r]);
  float ps = 0;
#pragma unroll
  for (int r = 0; r < 16; ++r) ps += p0[r];
#pragma unroll
  for (int r = 0; r < 16; ++r) ps += p1[r];
  { auto rr = __builtin_amdgcn_permlane32_swap(__float_as_uint(ps), __float_as_uint(ps), false, false);
    ps = __uint_as_float(rr[0]) + __uint_as_float(rr[1]); }
  l_reg = l_reg * alpha + ps;
#define PK4(P, BASE, OUT) do { unsigned a0 = cvtpk(P[BASE + 0], P[BASE + 1]), a1 = cvtpk(P[BASE + 2], P[BASE + 3]);   \
    unsigned b0 = cvtpk(P[BASE + 4], P[BASE + 5]), b1 = cvtpk(P[BASE + 6], P[BASE + 7]);                              \
    auto r0 = __builtin_amdgcn_permlane32_swap(a0, b0, false, false); auto r1 = __builtin_amdgcn_permlane32_swap(a1, b1, false, false); \
    u32x4 w = {r0[0], r1[0], r0[1], r1[1]}; OUT = *reinterpret_cast<bf16x8*>(&w); } while (0)
  PK4(p0, 0, pa0); PK4(p0, 8, pa1); PK4(p1, 0, pa2); PK4(p1, 8, pa3);
#undef PK4
}
__device__ __forceinline__ void kmask(f32x16& p0, f32x16& p1, int nv, int hi) {
#pragma unroll
  for (int r = 0; r < 16; ++r) { const int k = crow(r, hi); if (k >= nv) p0[r] = -1e30f; if (k + 32 >= nv) p1[r] = -1e30f; }
}
template <int OFF> __device__ __forceinline__ bf16x8 dsr128(int addr) { bf16x8 r; asm volatile("ds_read_b128 %0, %1 offset:%2" : "=&v"(r) : "v"(addr), "i"(OFF) : "memory"); return r; }
#define LGKM_W2(n, x, y) asm volatile("s_waitcnt lgkmcnt(" #n ")" : "+v"(x), "+v"(y) :: "memory")
#define LGKM_W3(n, x, y, z) asm volatile("s_waitcnt lgkmcnt(" #n ")" : "+v"(x), "+v"(y), "+v"(z) :: "memory")
__device__ __forceinline__ void qkt(f32x16& p0, f32x16& p1, const char* Kn, const char* Kr, const char* Qr, const bf16x8* qr, int lane) {
  p0 = f32x16{}; p1 = f32x16{};
  const int kn = (int)(uintptr_t)Kn + (lane & 31) * 16 + (lane >> 5) * 1024, kr = (int)(uintptr_t)Kr + (lane & 31) * 16 + (lane >> 5) * 1024, qa = (int)(uintptr_t)Qr + lane * 16;
  bf16x8 a0, a1, b0, b1, qa_, qb_;
#define MM(K0, K1, QQ) do { p0 = __builtin_amdgcn_mfma_f32_32x32x16_bf16(K0, QQ, p0, 0, 0, 0); p1 = __builtin_amdgcn_mfma_f32_32x32x16_bf16(K1, QQ, p1, 0, 0, 0); } while (0)
  a0 = dsr128<0 * 2048>(kn); a1 = dsr128<0 * 2048 + 512>(kn);
  b0 = dsr128<1 * 2048>(kn); b1 = dsr128<1 * 2048 + 512>(kn); LGKM_W2(2, a0, a1); MM(a0, a1, qr[0]);
  a0 = dsr128<2 * 2048>(kn); a1 = dsr128<2 * 2048 + 512>(kn); LGKM_W2(2, b0, b1); MM(b0, b1, qr[1]);
  b0 = dsr128<3 * 2048>(kn); b1 = dsr128<3 * 2048 + 512>(kn); LGKM_W2(2, a0, a1); MM(a0, a1, qr[2]);
  a0 = dsr128<4 * 2048>(kn); a1 = dsr128<4 * 2048 + 512>(kn); LGKM_W2(2, b0, b1); MM(b0, b1, qr[3]);
  b0 = dsr128<5 * 2048>(kn); b1 = dsr128<5 * 2048 + 512>(kn); LGKM_W2(2, a0, a1); MM(a0, a1, qr[4]);
  a0 = dsr128<6 * 2048>(kn); a1 = dsr128<6 * 2048 + 512>(kn); LGKM_W2(2, b0, b1); MM(b0, b1, qr[5]);
  b0 = dsr128<7 * 2048>(kn); b1 = dsr128<7 * 2048 + 512>(kn); LGKM_W2(2, a0, a1); MM(a0, a1, qr[6]);
  a0 = dsr128<0 * 2048>(kr); a1 = dsr128<0 * 2048 + 512>(kr); qa_ = dsr128<0 * 1024>(qa); LGKM_W2(3, b0, b1); MM(b0, b1, qr[7]);
  b0 = dsr128<1 * 2048>(kr); b1 = dsr128<1 * 2048 + 512>(kr); qb_ = dsr128<1 * 1024>(qa); LGKM_W3(3, a0, a1, qa_); MM(a0, a1, qa_);
  a0 = dsr128<2 * 2048>(kr); a1 = dsr128<2 * 2048 + 512>(kr); qa_ = dsr128<2 * 1024>(qa); LGKM_W3(3, b0, b1, qb_); MM(b0, b1, qb_);
  b0 = dsr128<3 * 2048>(kr); b1 = dsr128<3 * 2048 + 512>(kr); qb_ = dsr128<3 * 1024>(qa); LGKM_W3(3, a0, a1, qa_); MM(a0, a1, qa_);
  LGKM_W3(0, b0, b1, qb_); MM(b0, b1, qb_);
#undef MM
}
__device__ __forceinline__ int v_st(int k, int c) { const int kk = (k & ~0xC) | ((k & 4) << 1) | ((k & 8) >> 1); return ((kk >> 3) * 4 + (c >> 5)) * 512 + ((kk & 7) * 32 + (c & 31)) * 2; }
__device__ __forceinline__ int v_rd_base(int lane) { return ((lane & 3) << 3) | (((lane >> 2) & 3) << 6) | (((lane >> 4) & 1) << 5) | (((lane >> 5) & 1) << 8); }
constexpr int v_rd_off(int d0, int ks, int half) { return d0 * 512 + ks * 4096 + half * 2048; }
template <int OFF> __device__ __forceinline__ s16x4 tr_read(int vb) {
  s16x4 r; asm volatile("ds_read_b64_tr_b16 %0, %1 offset:%2" : "=&v"(r) : "v"(vb), "i"(OFF) : "memory"); return r;
}
struct VF { s16x4 l0, h0, l1, h1, l2, h2, l3, h3; };
template <int D0> __device__ __forceinline__ void pv_rd(VF& f, int vb) {
  f.l0 = tr_read<v_rd_off(D0, 0, 0)>(vb); f.h0 = tr_read<v_rd_off(D0, 0, 1)>(vb); f.l1 = tr_read<v_rd_off(D0, 1, 0)>(vb); f.h1 = tr_read<v_rd_off(D0, 1, 1)>(vb);
  f.l2 = tr_read<v_rd_off(D0, 2, 0)>(vb); f.h2 = tr_read<v_rd_off(D0, 2, 1)>(vb); f.l3 = tr_read<v_rd_off(D0, 3, 0)>(vb); f.h3 = tr_read<v_rd_off(D0, 3, 1)>(vb);
}
#define PV_WAIT(n, f) asm volatile("s_waitcnt lgkmcnt(" #n ")" : "+v"(f.l0), "+v"(f.h0), "+v"(f.l1), "+v"(f.h1), "+v"(f.l2), "+v"(f.h2), "+v"(f.l3), "+v"(f.h3) :: "memory")
__device__ __forceinline__ void pv_mm(f32x16& od, const VF& f, bf16x8 pa0, bf16x8 pa1, bf16x8 pa2, bf16x8 pa3) {
#define PK(L, H) (bf16x8){L[0], L[1], L[2], L[3], H[0], H[1], H[2], H[3]}
  od = __builtin_amdgcn_mfma_f32_32x32x16_bf16(pa0, PK(f.l0, f.h0), od, 0, 0, 0);
  od = __builtin_amdgcn_mfma_f32_32x32x16_bf16(pa1, PK(f.l1, f.h1), od, 0, 0, 0);
  od = __builtin_amdgcn_mfma_f32_32x32x16_bf16(pa2, PK(f.l2, f.h2), od, 0, 0, 0);
  od = __builtin_amdgcn_mfma_f32_32x32x16_bf16(pa3, PK(f.l3, f.h3), od, 0, 0, 0);
#undef PK
}
__device__ __forceinline__ void pv_d0(f32x16* o, int vb, bf16x8 pa0, bf16x8 pa1, bf16x8 pa2, bf16x8 pa3) {
  VF fa, fb;
  pv_rd<0>(fa, vb);
  pv_rd<1>(fb, vb); PV_WAIT(8, fa); pv_mm(o[0], fa, pa0, pa1, pa2, pa3);
  pv_rd<2>(fa, vb); PV_WAIT(8, fb); pv_mm(o[1], fb, pa0, pa1, pa2, pa3);
  pv_rd<3>(fb, vb); PV_WAIT(8, fa); pv_mm(o[2], fa, pa0, pa1, pa2, pa3);
  PV_WAIT(0, fb); pv_mm(o[3], fb, pa0, pa1, pa2, pa3);
}
__device__ __forceinline__ unsigned short f2bf16(float f) { unsigned u = __builtin_bit_cast(unsigned, f); return (unsigned short)((u + 0x7fffu + ((u >> 16) & 1u)) >> 16); }

__device__ __forceinline__ void attn_unit(const bf16* __restrict__ Qg, const bf16* __restrict__ KNg, const bf16* __restrict__ KRg, const bf16* __restrict__ Vg, bf16* __restrict__ AO,
                                          long row0, int L, int h, int q0, char* lds, int tbeg, int NT, float* part, unsigned* cnt, int piece) {
  int tid = threadIdx.x; asm volatile("" : "+v"(tid));
  const int wid = __builtin_amdgcn_readfirstlane(tid >> 6), lane = tid & 63, r32 = lane & 31, hi = lane >> 5;
  char* V_lds = lds + OFF_V; char* KN_lds = lds + OFF_KN; char* KR_lds = lds + OFF_KR;
  float* ws = (float*)(lds + OFF_WS) + wid * 64; float* li_l = ws; float* al_l = ws + 32;
  float m_reg = -1e30f, l_reg = 0; f32x16 o[4] = {}; bf16x8 qr[8]; char* QR_lds = lds + OFF_QR + wid * 4096;
  const bf16* Qw = Qg + (row0 + q0 + wid * 32 + r32) * 768;
#pragma unroll
  for (int d0 = 0; d0 < 8; ++d0) qr[d0] = ld8(Qw + 128 * h + d0 * 16 + hi * 8);
  { const bf16x8 t0 = ld8(Qw + 512 + 32 * h + hi * 8), t1 = ld8(Qw + 512 + 32 * h + 16 + hi * 8), t2 = ld8(Qw + 640 + 32 * h + hi * 8), t3 = ld8(Qw + 640 + 32 * h + 16 + hi * 8);
    *(bf16x8*)(QR_lds + lane * 16) = t0; *(bf16x8*)(QR_lds + lane * 16 + 1024) = t1;
    *(bf16x8*)(QR_lds + lane * 16 + 2048) = t2; *(bf16x8*)(QR_lds + lane * 16 + 3072) = t3; }
  const int sr = tid >> 4, sc = (tid & 15) * 8, vst0 = v_st(sr, sc), vst1 = v_st(32 + sr, sc);
  const int krow = 8 * wid + (lane & 7), kc8 = lane >> 3;
  const int kwoff = (kc8 >> 1) * 2048 + (kc8 & 1) * 1024 + (krow >> 5) * 512 + (krow & 31) * 16;
  const int vb0 = (int)(uintptr_t)V_lds + v_rd_base(lane);
  const bf16* Vh = Vg + row0 * 512 + 128 * h;
  const bf16* Kh = KNg + row0 * 512 + 128 * h;
  const bf16* Rh = KRg + row0 * 64;
  const unsigned kvoff = (unsigned)(sr * 512 + sc), knoff = (unsigned)(krow * 512 + kc8 * 8), kroff = (unsigned)(krow * 64 + kc8 * 8);
  bf16x8 vs0, vs1, ks0, ks1, kr0;
#define KLOAD(k0) do { const bf16* kt_ = Kh + (long)(k0) * 512; const bf16* rt_ = Rh + (long)(k0) * 64; ks0 = ld8(kt_ + knoff); ks1 = ld8(kt_ + 64 + knoff); kr0 = ld8(rt_ + kroff); } while (0)
#define VLOAD(k0) do { const bf16* vt_ = Vh + (long)(k0) * 512; vs0 = ld8(vt_ + kvoff); vs1 = ld8(vt_ + 32 * 512 + kvoff); } while (0)
#define KWRITE(b) do { *(bf16x8*)(KN_lds + (b) * SHM_KN + kwoff) = ks0; *(bf16x8*)(KN_lds + (b) * SHM_KN + 8192 + kwoff) = ks1; *(bf16x8*)(KR_lds + (b) * SHM_KR + kwoff) = kr0; } while (0)
#define VWRITE(b) do { *(bf16x8*)(V_lds + (b) * SHM_V + vst0) = vs0; *(bf16x8*)(V_lds + (b) * SHM_V + vst1) = vs1; } while (0)
#define SWAIT() asm volatile("s_waitcnt vmcnt(0)" ::: "memory")
#define RESC(a) do { if (__any((a) < 1.f)) { if (hi == 0) al_l[r32] = (a); asm volatile("s_waitcnt lgkmcnt(0)" ::: "memory"); \
    _Pragma("unroll") for (int d = 0; d < 4; ++d) _Pragma("unroll") for (int r = 0; r < 16; ++r) o[d][r] *= al_l[crow(r, hi)]; } } while (0)
  f32x16 pA0, pA1, pB0, pB1; float mnA, mnB, alA, alB; bf16x8 pa0, pa1, pa2, pa3;
  const int NTt = (L + KVBLK - 1) / KVBLK, nv_last = L - (NTt - 1) * KVBLK;
  if (wid >= 4) __builtin_amdgcn_s_setprio(1);
  KLOAD(tbeg * KVBLK); VLOAD(tbeg * KVBLK); SWAIT(); KWRITE(0); VWRITE(0); __syncthreads();
  qkt(pA0, pA1, KN_lds, KR_lds, QR_lds, qr, lane);
  KLOAD((tbeg + 1) * KVBLK);
  partialSM(pA0, pA1, m_reg, mnA, alA);
  SWAIT(); KWRITE(1); __syncthreads();
  for (int j = 1; j + 1 < NT; j += 2) {
    SBAR(); qkt(pB0, pB1, KN_lds + SHM_KN, KR_lds + SHM_KR, QR_lds, qr, lane);
    finishSM(pA0, pA1, alA, l_reg, pa0, pa1, pa2, pa3); SBAR();
    KLOAD((tbeg + j + 1) * KVBLK); VLOAD((tbeg + j) * KVBLK); SBAR();
    pv_d0(o, vb0, pa0, pa1, pa2, pa3); partialSM(pB0, pB1, m_reg, mnB, alB);
    RESC(alB);
    SWAIT(); KWRITE(0); VWRITE(1); __syncthreads();
    SBAR(); qkt(pA0, pA1, KN_lds, KR_lds, QR_lds, qr, lane);
    finishSM(pB0, pB1, alB, l_reg, pa0, pa1, pa2, pa3); SBAR();
    const bool more = (j + 2 < NT);
    if (more) KLOAD((tbeg + j + 2) * KVBLK);
    VLOAD((tbeg + j + 1) * KVBLK); SBAR();
    pv_d0(o, vb0 + SHM_V, pa0, pa1, pa2, pa3);
    if (tbeg + j + 1 == NTt - 1) kmask(pA0, pA1, nv_last, hi);
    partialSM(pA0, pA1, m_reg, mnA, alA);
    RESC(alA);
    SWAIT(); if (more) KWRITE(1); VWRITE(0); __syncthreads();
  }
  finishSM(pA0, pA1, alA, l_reg, pa0, pa1, pa2, pa3); SBAR();
  pv_d0(o, vb0, pa0, pa1, pa2, pa3);
  __builtin_amdgcn_s_setprio(0);
  int lane_e = lane, wid_e = wid, q0_e = q0, h_e = h, L_e = L; long row0_e = row0; char* lds_e = lds;
  asm volatile("" : "+v"(lane_e)); asm volatile("" : "+s"(wid_e), "+s"(q0_e), "+s"(h_e), "+s"(L_e), "+s"(row0_e), "+s"(lds_e));
  if (part != nullptr) {
    __syncthreads();
    if (wid_e == 0) { const int r32e = lane_e & 31, hie = lane_e >> 5;
#pragma unroll
      for (int r = 0; r < 8; ++r) { const int orow = crow(r, hie);
#pragma unroll
        for (int d0 = 0; d0 < 4; ++d0) part[(piece * 16 + orow) * 132 + d0 * 32 + r32e] = o[d0][r]; }
      if (lane_e < 16) { part[(piece * 16 + lane_e) * 132 + 128] = m_reg; part[(piece * 16 + lane_e) * 132 + 129] = l_reg; } }
    __threadfence();
    __syncthreads();
    __attribute__((address_space(3))) unsigned* flag = (__attribute__((address_space(3))) unsigned*)(lds_e + OFF_FLAG);
    if (wid_e == 0 && lane_e == 0) { const unsigned old = __hip_atomic_fetch_add(cnt, 1u, __ATOMIC_RELAXED, __HIP_MEMORY_SCOPE_AGENT); *flag = old; }
    __syncthreads();
    const bool last = (*(volatile __attribute__((address_space(3))) unsigned*)flag == (unsigned)(NPIECE - 1));
    if (last) {
      __threadfence();
      constexpr float C = SCALE * 1.4426950408889634f;
      const int t = wid_e * 64 + lane_e, row = t >> 5, c4 = (t & 31) * 4;
      float mmax = -3.0e38f;
#pragma unroll
      for (int i = 0; i < NPIECE; ++i) mmax = fmaxf(mmax, (*(part + (i * 16 + row) * 132 + 128)));
      float lsum = 0.f; float a0 = 0.f, a1 = 0.f, a2 = 0.f, a3 = 0.f;
#pragma unroll
      for (int i = 0; i < NPIECE; ++i) { const float* pr = part + (i * 16 + row) * 132;
        const float w = __builtin_amdgcn_exp2f(((*(pr + 128)) - mmax) * C); lsum += (*(pr + 129)) * w;
        a0 += (*(pr + c4)) * w; a1 += (*(pr + c4 + 1)) * w; a2 += (*(pr + c4 + 2)) * w; a3 += (*(pr + c4 + 3)) * w; }
      const float rl = 1.0f / lsum;
      const unsigned w0 = (unsigned)f2bf16(a0 * rl) | ((unsigned)f2bf16(a1 * rl) << 16), w1 = (unsigned)f2bf16(a2 * rl) | ((unsigned)f2bf16(a3 * rl) << 16);
      unsigned* dst = (unsigned*)(AO + (row0_e + q0_e + row) * 1024 + 128 * h_e + c4);
      dst[0] = w0; dst[1] = w1;
    }
    __syncthreads();
    return;
  }
  if (hi == 0) li_l[r32] = l_reg; asm volatile("s_waitcnt lgkmcnt(0)" ::: "memory");
  float rli[16];
#pragma unroll
  for (int r = 0; r < 16; ++r) rli[r] = __builtin_amdgcn_rcpf(li_l[crow(r, hi)]);
  __syncthreads();
  __attribute__((address_space(3))) unsigned short* stg = (__attribute__((address_space(3))) unsigned short*)(lds_e + wid_e * 8192);
  { const int r32e = lane_e & 31, hie = lane_e >> 5;
#pragma unroll
  for (int r = 0; r < 16; ++r) { const int orow = crow(r, hie);
#pragma unroll
    for (int d0 = 0; d0 < 4; ++d0) stg[orow * 128 + d0 * 32 + r32e] = f2bf16(o[d0][r] * rli[r]); } }
  asm volatile("s_waitcnt lgkmcnt(0)" ::: "memory");
  const int qw = q0_e + wid_e * 32;
  bf16* AOw = AO + (row0_e + qw) * 1024 + 128 * h_e + (lane_e & 15) * 8;
#pragma unroll
  for (int i = 0; i < 8; ++i) { const int row = i * 4 + (lane_e >> 4); const u32x4 v = *(const __attribute__((address_space(3))) u32x4*)(stg + row * 128 + (lane_e & 15) * 8);
    if (qw + row < L_e) *(u32x4*)(AOw + (long)row * 1024) = v; }
  asm volatile("s_waitcnt lgkmcnt(0)" ::: "memory");
  __syncthreads();
#undef KLOAD
#undef VLOAD
#undef KWRITE
#undef VWRITE
#undef SWAIT
#undef RESC
}
#undef SBAR
}


#define LAS __attribute__((address_space(3)))
typedef unsigned short bf16;
typedef unsigned v4u __attribute__((ext_vector_type(4)));
typedef unsigned v2u __attribute__((ext_vector_type(2)));
typedef float f32x4 __attribute__((ext_vector_type(4)));
constexpr int NWAVES = 8;
constexpr int LDS_BYTES = 147456;
constexpr int NPH = 1 + 8 * NLAYER;
constexpr int N_LAUNCHES = MK_N_LAUNCHES;

constexpr size_t MiB = 1u << 20;
constexpr size_t SZ_WIN = (size_t)NZ * 1024 * 2, SZ_WQ = 768 * 384 * 2, SZ_WKV = 1024 * 256 * 2, SZ_WO = 1024 * 1024 * 2, SZ_WGU = (size_t)5632 * 1024 * 2, SZ_WD = (size_t)1024 * 2816 * 2;
constexpr size_t OFFW_IN = 0, OFFW_Q = OFFW_IN + SZ_WIN, OFFW_KV = OFFW_Q + SZ_WQ, OFFW_O = OFFW_KV + SZ_WKV, OFFW_GU = OFFW_O + SZ_WO, OFFW_D = OFFW_GU + SZ_WGU, SZ_WLAYER = OFFW_D + SZ_WD;
constexpr size_t WS_CTL = 0, WS_BAR = 16384, WS_PART = 65536;
constexpr int LDS_BARST = 147456 - 64;
constexpr size_t WS_W = 1 * MiB, WS_ROPE = 50 * MiB, WS_SSQ = 55 * MiB, WS_SSQX = 63 * MiB + 512 * 1024, WS_X = 64 * MiB;
constexpr size_t WS_GB = 193 * MiB, WS_U = 257 * MiB + 512 * 1024, WS_ZQ = 322 * MiB, WS_AO = 322 * MiB, WS_F = 193 * MiB, WS_ACT1 = 322 * MiB;
constexpr int ACT_SPLIT = 138;
constexpr size_t WS_END = 512 * MiB;
constexpr size_t D_Q = 0, D_KN = (size_t)MP * 768 * 2, D_V = D_KN + (size_t)MP * 512 * 2, D_KR = D_V + (size_t)MP * 512 * 2, D_MIX = 0, D_ACT2 = 0;
static_assert(WS_W + 2 * SZ_WLAYER <= WS_ROPE && WS_ROPE + (size_t)L_S * 64 * 4 <= WS_SSQ && WS_SSQ + (size_t)MP * 32 * 4 <= WS_SSQX && WS_SSQX + (size_t)MP * 4 <= WS_X, "ws fixed region");
static_assert(WS_X + (size_t)MP * 1024 * 2 <= WS_GB && WS_GB + (size_t)MP * 512 * 2 <= WS_U && WS_U + (size_t)MP * 512 * 2 <= WS_ZQ && WS_ZQ + (size_t)MP * 768 * 2 <= WS_END, "ws map 1");
static_assert(WS_AO + (size_t)MP * 1024 * 2 <= WS_END && WS_F + (size_t)MP * 1024 * 2 <= WS_ACT1 && WS_ACT1 + (size_t)ACT_SPLIT * 256 * 2816 * 2 <= WS_END, "ws map 2");
static_assert(D_KR + (size_t)MP * 64 * 2 <= (size_t)256 * MiB && (size_t)(MP / 256 - ACT_SPLIT) * 256 * 2816 * 2 <= (size_t)256 * MiB && (size_t)MP * 1024 * 2 <= (size_t)256 * MiB, "d_out scratch map");

__device__ const double INVF[32] = {1.0, 0.7498942093324559, 0.5623413251903491, 0.4216965034285822, 0.31622776601683794, 0.23713737056616552, 0.1778279410038923, 0.1333521432163324, 0.1, 0.07498942093324558, 0.05623413251903491, 0.042169650342858224, 0.03162277660168379, 0.023713737056616554, 0.01778279410038923, 0.01333521432163324, 0.01, 0.007498942093324558, 0.005623413251903491, 0.004216965034285823, 0.0031622776601683794, 0.0023713737056616554, 0.0017782794100389228, 0.001333521432163324, 0.001, 0.0007498942093324559, 0.0005623413251903491, 0.00042169650342858224, 0.00031622776601683794, 0.00023713737056616554, 0.00017782794100389227, 0.0001333521432163324};

#define LDS_WAIT() asm volatile("s_waitcnt lgkmcnt(0)" ::: "memory")
__device__ __forceinline__ unsigned f2bf(float f) { unsigned u = __builtin_bit_cast(unsigned, f); return (u + 0x7fffu + ((u >> 16) & 1u)) >> 16; }
__device__ __forceinline__ unsigned pk2(float lo, float hi) { return f2bf(lo) | (f2bf(hi) << 16); }
__device__ __forceinline__ float bflo(unsigned w) { return __builtin_bit_cast(float, w << 16); }
__device__ __forceinline__ float bfhi(unsigned w) { return __builtin_bit_cast(float, w & 0xffff0000u); }
__device__ __forceinline__ float wave_sum(float v) {
#pragma unroll
    for (int o = 1; o < 64; o <<= 1) v += __shfl_xor(v, o);
    return v;
}
__device__ __forceinline__ float half_sum32(float v) {
#pragma unroll
    for (int o = 1; o < 32; o <<= 1) v += __shfl_xor(v, o);
    return v;
}

struct Args { const float* in[17]; float* out; unsigned char* ws; int ph_lo, ph_hi; };

__device__ __forceinline__ void p0_transpose_item(const float* W, int Nsrc, int K, int sc0, const float* g, bf16* WT, int dr0, int k0, LAS float* scr, int lane) {
    if (sc0 >= 0) {
#pragma unroll 8
        for (int i = 0; i < 32; ++i) { const int kk = 2 * i + (lane >> 5); const float gv = g ? g[k0 + kk] : 1.0f; scr[kk * 33 + (lane & 31)] = W[(size_t)(k0 + kk) * Nsrc + sc0 + (lane & 31)] * gv; }
    } else {
#pragma unroll 8
        for (int i = 0; i < 32; ++i) { const int kk = 2 * i + (lane >> 5); scr[kk * 33 + (lane & 31)] = 0.0f; }
    }
    LDS_WAIT(); asm volatile("" ::: "memory");
    const int c = lane & 7;
#pragma unroll
    for (int j = 0; j < 4; ++j) { const int n = (lane >> 3) + 8 * j; const LAS float* s = scr + (8 * c) * 33 + n;
        v4u o; o.x = pk2(s[0 * 33], s[1 * 33]); o.y = pk2(s[2 * 33], s[3 * 33]); o.z = pk2(s[4 * 33], s[5 * 33]); o.w = pk2(s[6 * 33], s[7 * 33]);
        *(v4u*)(WT + (size_t)(dr0 + n) * K + k0 + 8 * c) = o; }
    LDS_WAIT(); asm volatile("" ::: "memory");
}

__device__ __forceinline__ void p0_prologue(const Args& a, LAS unsigned char* lds, int gw, int NGW, int wave, int lane) {
    LAS float* scr = (LAS float*)(lds + wave * 16384);
    unsigned char* ws = a.ws;
    if (gw == 0 && lane < 2 * 8) ((unsigned*)(ws + WS_CTL))[lane * 64] = 0u;
    if (gw < NWAVES) { for (int i = gw * 64 + lane; i < 3456; i += NWAVES * 64) ((unsigned*)(ws + WS_BAR))[i] = 0u; }
    constexpr int I0 = 16 * 72, I1 = 6 * 24, I2 = 4 * 32, I3 = 16 * 32, I4 = 16 * 176, I5 = 44 * 32, IL = I0 + I1 + I2 + I3 + I4 + I5;
    for (int it = gw; it < NLAYER * IL; it += NGW) {
        const int l = it / IL; int r = it % IL;
        bf16* wl = (bf16*)(ws + WS_W + (size_t)l * SZ_WLAYER);
        if (r < I0) {
            const int kb = r / 72, nb = r % 72, n0 = nb * 32; int sc;
            if (n0 < 704) sc = n0; else if (n0 < 768) sc = -1; else if (n0 < 1280) sc = n0 - 64;
            else { const int t = (n0 - 1280) >> 8, w = (n0 - 1280) & 255; sc = (w < 128) ? 1216 + 128 * t + w : 1728 + 128 * t + (w - 128); }
            p0_transpose_item(a.in[4] + (size_t)l * 1024 * 2240, 2240, 1024, sc, a.in[3] + l * 1024, (bf16*)((unsigned char*)wl + OFFW_IN), n0, kb * 64, scr, lane); continue; }
        r -= I0;
        if (r < I1) {
            const int kb = r / 24, nb = r % 24, n0 = nb * 32; int sc;
            if (n0 < 512) sc = 192 * (n0 >> 7) + (n0 & 127); else if (n0 < 640) sc = 192 * ((n0 - 512) >> 5) + 128; else sc = 192 * ((n0 - 640) >> 5) + 160;
            p0_transpose_item(a.in[6] + (size_t)l * 384 * 768, 768, 384, sc, a.in[5] + l * 384, (bf16*)((unsigned char*)wl + OFFW_Q), n0, kb * 64, scr, lane); continue; }
        r -= I1;
        if (r < I2) {
            const int kb = r / 32, nb = r % 32, n0 = nb * 32; int sc;
            if (n0 < 512) sc = 256 * (n0 >> 7) + (n0 & 127); else sc = 256 * ((n0 - 512) >> 7) + 128 + ((n0 - 512) & 127);
            p0_transpose_item(a.in[8] + (size_t)l * 256 * 1024, 1024, 256, sc, a.in[7] + l * 256, (bf16*)((unsigned char*)wl + OFFW_KV), n0, kb * 64, scr, lane); continue; }
        r -= I2;
        if (r < I3) {
            const int kb = r / 32, nb = r % 32, n0 = nb * 32;
            p0_transpose_item(a.in[10] + (size_t)l * 1024 * 1024, 1024, 1024, n0, nullptr, (bf16*)((unsigned char*)wl + OFFW_O), n0, kb * 64, scr, lane); continue; }
        r -= I3;
        if (r < I4) {
            const int kb = r / 176, nb = r % 176, n0 = nb * 32; const int t = n0 >> 8, w = n0 & 255;
            const float* src = (w < 128) ? a.in[13] : a.in[14]; const int sc = 128 * t + (w & 127);
            p0_transpose_item(src + (size_t)l * 1024 * 2816, 2816, 1024, sc, a.in[12] + l * 1024, (bf16*)((unsigned char*)wl + OFFW_GU), n0, kb * 64, scr, lane); continue; }
        r -= I4;
        {
            const int kb = r / 32, nb = r % 32, n0 = nb * 32;
            p0_transpose_item(a.in[15] + (size_t)l * 2816 * 1024, 1024, 2816, n0, nullptr, (bf16*)((unsigned char*)wl + OFFW_D), n0, kb * 64, scr, lane); }
    }
    {
        float* rope = (float*)(ws + WS_ROPE);
        const int gt = gw * 64 + lane, NGT = NGW * 64;
        for (int idx = gt; idx < L_S * 32; idx += NGT) {
            const int pos = idx >> 5, i = idx & 31;
            const double ang = (double)pos * INVF[i];
            const double TWO_PI = 6.283185307179586476925286766559;
            const double kq = __builtin_rint(ang * (1.0 / TWO_PI));
            const double rr = __builtin_fma(-kq, TWO_PI, ang);
            const double x = rr * 0.125, x2 = x * x;
            double sn = x * (1.0 + x2 * (-1.0 / 6.0 + x2 * (1.0 / 120.0 + x2 * (-1.0 / 5040.0 + x2 * (1.0 / 362880.0 + x2 * (-1.0 / 39916800.0))))));
            double cs = 1.0 + x2 * (-0.5 + x2 * (1.0 / 24.0 + x2 * (-1.0 / 720.0 + x2 * (1.0 / 40320.0 + x2 * (-1.0 / 3628800.0 + x2 * (1.0 / 479001600.0))))));
#pragma unroll
            for (int d = 0; d < 3; ++d) { const double s2 = 2.0 * sn * cs, c2 = cs * cs - sn * sn; sn = s2; cs = c2; }
            rope[(size_t)pos * 64 + i] = (float)cs; rope[(size_t)pos * 64 + 32 + i] = (float)sn;
        }
    }
    {
        bf16* X = (bf16*)(ws + WS_X); float* ssqX = (float*)(ws + WS_SSQX);
        for (int r = gw; r < MP; r += NGW) {
            v2u* o8 = (v2u*)(X + (size_t)r * 1024) + lane;
            if (r >= M_REAL) {
#pragma unroll
                for (int j = 0; j < 4; ++j) o8[64 * j] = (v2u){0u, 0u};
                if (lane == 0) ssqX[r] = 0.0f;
                continue;
            }
            const float* src;
            if (r < ROWS_P) { const int s = r / L_P, pos = r - s * L_P; src = (pos < 16) ? a.in[2] + pos * 1024 : a.in[0] + ((size_t)s * 2048 + (pos - 16)) * 1024; }
            else { const int q = r - ROWS_P, s = q / L_S, pos = q - s * L_S; src = (pos < 16) ? a.in[2] + pos * 1024 : a.in[1] + ((size_t)s * 16384 + (pos - 16)) * 1024; }
            const f32x4* xr = (const f32x4*)src + lane;
            f32x4 v[4]; float s2 = 0.f;
#pragma unroll
            for (int j = 0; j < 4; ++j) { v[j] = xr[64 * j]; s2 += (v[j].x * v[j].x + v[j].y * v[j].y) + (v[j].z * v[j].z + v[j].w * v[j].w); }
            s2 = wave_sum(s2);
#pragma unroll
            for (int j = 0; j < 4; ++j) o8[64 * j] = (v2u){pk2(v[j].x, v[j].y), pk2(v[j].z, v[j].w)};
            if (lane == 0) ssqX[r] = s2;
        }
    }
}

__device__ __forceinline__ void kr_pass(const bf16* ZQ, const float* rope, bf16* KR, int gw, int NGW, int lane) {
    const int i = lane & 31;
    for (int r = gw; r < MP; r += NGW) {
        const int pos = pg8::row_pos(r);
        const bf16* z = ZQ + (size_t)r * 768 + 640;
        const float x1 = bflo((unsigned)z[i]), x2 = bflo((unsigned)z[32 + i]);
        const float c = rope[(size_t)pos * 64 + i], s = rope[(size_t)pos * 64 + 32 + i];
        const float y = (lane < 32) ? (x1 * c - x2 * s) : (x2 * c + x1 * s);
        KR[(size_t)r * 64 + lane] = (bf16)f2bf(y);
    }
}
__device__ __forceinline__ void conv_pass(const bf16* GB, const bf16* U, const float* cw  , bf16* AO, int gw, int NGW, int lane) {
    const int c0 = lane * 8;
    f32x4 w[3][2];
#pragma unroll
    for (int k = 0; k < 3; ++k) { w[k][0] = *(const f32x4*)(cw + k * 512 + c0); w[k][1] = *(const f32x4*)(cw + k * 512 + c0 + 4); }
    for (int r = gw; r < MP; r += NGW) {
        v4u* dst = (v4u*)(AO + (size_t)r * 1024 + 512 + c0);
        if (r >= M_REAL) { *dst = (v4u){0u, 0u, 0u, 0u}; *(v4u*)(AO + (size_t)r * 1024 + c0) = (v4u){0u, 0u, 0u, 0u}; continue; }
        int pos, L;
        if (r < ROWS_P) { pos = r % L_P; L = L_P; } else { pos = (r - ROWS_P) % L_S; L = L_S; }
        const v4u g = *(const v4u*)(GB + (size_t)r * 512 + c0);
        const v4u u1 = *(const v4u*)(U + (size_t)r * 512 + c0);
        v4u u0 = (v4u){0u, 0u, 0u, 0u}, u2 = (v4u){0u, 0u, 0u, 0u};
        if (pos > 0) u0 = *(const v4u*)(U + (size_t)(r - 1) * 512 + c0);
        if (pos < L - 1) u2 = *(const v4u*)(U + (size_t)(r + 1) * 512 + c0);
        v4u o;
#pragma unroll
        for (int q = 0; q < 4; ++q) {
            const int h = q >> 1, e = (q & 1) * 2;
            const float lo = bflo(g[q]) * (w[0][h][e] * bflo(u0[q]) + w[1][h][e] * bflo(u1[q]) + w[2][h][e] * bflo(u2[q]));
            const float hi = bfhi(g[q]) * (w[0][h][e + 1] * bfhi(u0[q]) + w[1][h][e + 1] * bfhi(u1[q]) + w[2][h][e + 1] * bfhi(u2[q]));
            o[q] = pk2(lo, hi);
        }
        *dst = o;
    }
}
__device__ __forceinline__ void nr_pass(bf16* X, const bf16* Y, const float* SSQ, float* ssqX, const float* g, float* out  , int gw, int NGW, int lane) {
    f32x4 gv[4];
#pragma unroll
    for (int j = 0; j < 4; ++j) gv[j] = *((const f32x4*)g + lane + 64 * j);
    for (int r = gw; r < M_REAL; r += NGW) {
        const float part = SSQ[(size_t)r * 32 + (lane & 31)];
        const float s = rsqrtf(half_sum32(part) * (1.0f / 1024.0f) + EPS);
        v2u* x8 = (v2u*)(X + (size_t)r * 1024) + lane; const v2u* y8 = (const v2u*)(Y + (size_t)r * 1024) + lane;
        f32x4 v[4]; float s2 = 0.f;
#pragma unroll
        for (int j = 0; j < 4; ++j) { const v2u xv = x8[64 * j], yv = y8[64 * j];
            v[j].x = bflo(xv.x) + bflo(yv.x) * s * gv[j].x; v[j].y = bfhi(xv.x) + bfhi(yv.x) * s * gv[j].y;
            v[j].z = bflo(xv.y) + bflo(yv.y) * s * gv[j].z; v[j].w = bfhi(xv.y) + bfhi(yv.y) * s * gv[j].w;
            s2 += (v[j].x * v[j].x + v[j].y * v[j].y) + (v[j].z * v[j].z + v[j].w * v[j].w); }
        if (out == nullptr) {
            s2 = wave_sum(s2);
#pragma unroll
            for (int j = 0; j < 4; ++j) x8[64 * j] = (v2u){pk2(v[j].x, v[j].y), pk2(v[j].z, v[j].w)};
            if (lane == 0) ssqX[r] = s2;
        } else {
            int pos; size_t orow;
            if (r < ROWS_P) { const int sq = r / L_P; pos = r - sq * L_P; orow = (size_t)sq * 2048 + (pos - 16); }
            else { const int q = r - ROWS_P, sq = q / L_S; pos = q - sq * L_S; orow = (size_t)NSEQ_P * 2048 + (size_t)sq * 16384 + (pos - 16); }
            if (pos >= 16) { f32x4* o = (f32x4*)(out + orow * 1024) + lane;
#pragma unroll
                for (int j = 0; j < 4; ++j) o[64 * j] = v[j]; }
        }
    }
}

constexpr int NU_S = 512, NU_PC = 56, NU_P = 576, NU = NU_S + NU_PC + NU_P;
__device__ __forceinline__ int attn_next(int i, int G, int bx) {
    if (G == 256) {
        const int vcu = (bx & 7) * 32 + (bx >> 3), x = vcu >> 5, c = vcu & 31;
        if (i == 0) return 64 * x + c;
        if (i == 1) return 64 * x + 32 + c;
        const int e = c + 32 * (i - 2);
        if (e >= 79) return -1;
        if (e < 15) return NU_S + NU_PC + 72 * x + e;
        if (e < 22) return NU_S + 7 * x + (e - 15);
        return NU_S + NU_PC + 72 * x + (e - 7);
    }
    const int id = i * G + bx; return (id < NU) ? id : -1;
}

#define XB_TMO      128
#define XB_XCNT(j)  (256  + 64 * (j))
#define XB_XSUB(j)  (1280 + 64 * (j))
#define XB_XGEN(j)  (2304 + 64 * (j))
#define XB_TOP      3328
#define XB_TOPGEN   3392
#define XCD_BAR_WORDS 3456
#define XB_SPIN_CAP (1u << 18)

__device__ __forceinline__ unsigned xb_ld(unsigned* p)              { return __hip_atomic_load(p, __ATOMIC_RELAXED, __HIP_MEMORY_SCOPE_AGENT); }
__device__ __forceinline__ unsigned xb_add(unsigned* p, unsigned v) { return __hip_atomic_fetch_add(p, v, __ATOMIC_RELAXED, __HIP_MEMORY_SCOPE_AGENT); }
__device__ __forceinline__ unsigned xb_xcc_id() { return (unsigned)__builtin_amdgcn_s_getreg((3 << 11) | 20) & 0xFu; }
#define XB_SPIN(cond, bar) do { unsigned _sp = 0; while (cond) { __builtin_amdgcn_s_sleep(1); \
    if ((++_sp & 255u) == 0u) { if (xb_ld(&(bar)[XB_TMO])) break; if (_sp > XB_SPIN_CAP) { atomicAdd(&(bar)[XB_TMO], 1u); break; } } } } while (0)

struct XcdBarrier {
    unsigned* bar; unsigned x;
    volatile LAS unsigned* st;
};

__device__ __forceinline__ XcdBarrier xcd_barrier_post(unsigned* bar, volatile LAS unsigned* st) {
    XcdBarrier b; b.bar = bar; b.x = xb_xcc_id(); b.st = st;
    if (threadIdx.x == 0) (void)xb_add(&bar[XB_XCNT(b.x)], 1u);
    return b;
}
__device__ __forceinline__ void xcd_barrier_complete(unsigned* bar, unsigned x, unsigned& nloc, unsigned& nx) {
    const unsigned G = gridDim.x * gridDim.y * gridDim.z;
    unsigned sum, cnt, mine, sp = 0u;
    for (;;) {
        sum = 0u; cnt = 0u; mine = 0u;
#pragma unroll
        for (unsigned j = 0; j < 16; ++j) { const unsigned c = xb_ld(&bar[XB_XCNT(j)]); sum += c; cnt += (c > 0u) ? 1u : 0u; mine = (j == x) ? c : mine; }
        if (sum == G) break;
        __builtin_amdgcn_s_sleep(1);
        if ((++sp & 255u) == 0u) { if (xb_ld(&bar[XB_TMO])) break; if (sp > XB_SPIN_CAP) { atomicAdd(&bar[XB_TMO], 1u); break; } }
    }
    nloc = mine > 0u ? mine : 1u; nx = cnt > 0u ? cnt : 1u;
}

__device__ __forceinline__ void xcd_barrier(const XcdBarrier& b) {
    asm volatile("s_waitcnt vmcnt(0)" ::: "memory");
    __syncthreads();
    if (threadIdx.x == 0) {
        unsigned* bar = b.bar;
        __builtin_amdgcn_s_waitcnt(0);
        unsigned nloc = b.st[0], nx = b.st[1];
        if (nloc == 0u) { xcd_barrier_complete(bar, b.x, nloc, nx); b.st[0] = nloc; b.st[1] = nx; }
        const unsigned old = xb_add(&bar[XB_XSUB(b.x)], 1u);
        const unsigned gen = old / nloc;
        if (old + 1u == (gen + 1u) * nloc) {
            __builtin_amdgcn_fence(__ATOMIC_RELEASE, "agent");
            asm volatile("s_waitcnt vmcnt(0)" ::: "memory");
            const unsigned og = xb_add(&bar[XB_TOP], 1u);
            const unsigned tg = og / nx;
            if (og + 1u == (tg + 1u) * nx) xb_add(&bar[XB_TOPGEN], 1u);
            else XB_SPIN(xb_ld(&bar[XB_TOPGEN]) == tg, bar);
            __builtin_amdgcn_fence(__ATOMIC_ACQUIRE, "agent");
            xb_add(&bar[XB_XGEN(b.x)], 1u);
            asm volatile("s_waitcnt vmcnt(0)" ::: "memory");
        } else {
            XB_SPIN(xb_ld(&bar[XB_XGEN(b.x)]) == gen, bar);
            __builtin_amdgcn_fence(__ATOMIC_ACQUIRE, "agent");
            asm volatile("s_waitcnt vmcnt(0)" ::: "memory");
        }
    }
    __syncthreads();
}

__device__ __forceinline__ int attn_next_last(int i, int G, int bx) {
    if (G == 256) {
        const int vcu = (bx & 7) * 32 + (bx >> 3), x = vcu >> 5, c = vcu & 31;
        if (i == 0) return 64 * x + c;
        if (i == 1) return 64 * x + 32 + c;
        if (i < 4) return 512 + 64 * x + c + 32 * (i - 2);
        return -1;
    }
    const int id = i * G + bx; return (id < 1024) ? id : -1;
}

#define GAS __attribute__((address_space(1)))
#define LAUNDER_BASES() GAS unsigned char* wsg_ = (GAS unsigned char*)a.ws; GAS unsigned char* dsg_ = (GAS unsigned char*)a.out; asm volatile("" : "+s"(wsg_), "+s"(dsg_)); \
    unsigned char* ws = (unsigned char*)wsg_; unsigned char* dsc = (unsigned char*)dsg_;     \
    int lane = threadIdx.x & 63, wave = __builtin_amdgcn_readfirstlane(threadIdx.x >> 6), G = gridDim.x, bx = blockIdx.x; \
    asm volatile("" : "+v"(lane)); asm volatile("" : "+s"(wave), "+s"(G), "+s"(bx)); \
    const int gw = bx * NWAVES + wave, NGW = G * NWAVES; (void)gw; (void)NGW; (void)lane; (void)dsc
#define P_X ((bf16*)(ws + WS_X))
#define P_GB ((bf16*)(ws + WS_GB))
#define P_U ((bf16*)(ws + WS_U))
#define P_ZQ ((bf16*)(ws + WS_ZQ))
#define P_AO ((bf16*)(ws + WS_AO))
#define P_F ((bf16*)(ws + WS_F))
#define P_ACT1 ((bf16*)(ws + WS_ACT1))
#define P_ACT2 ((bf16*)(dsc + D_ACT2))
#define P_Q ((bf16*)(dsc + D_Q))
#define P_KN ((bf16*)(dsc + D_KN))
#define P_V ((bf16*)(dsc + D_V))
#define P_KR ((bf16*)(dsc + D_KR))
#define P_MIX ((bf16*)(dsc + D_MIX))
#define P_SSQ ((float*)(ws + WS_SSQ))
#define P_SSQX ((float*)(ws + WS_SSQX))
#define P_ROPE ((const float*)(ws + WS_ROPE))
#define PH_IN(p) (lo <= (p) && (p) < hi && ((PHM >> ((p) == 0 ? 0 : (((p) - 1) & 7) + 1)) & 1))
#define PH_SYNC(p) do { if (lo <= (p) && (p) + 1 < hi) xcd_barrier(bar); } while (0)

template <int LYR>
__device__ __forceinline__ void layer_phases(const Args& a, const XcdBarrier& bar, unsigned char* lds, int lo, int hi) {
    LAS unsigned char* ldsl = (LAS unsigned char*)lds;
    constexpr int P0 = 1 + 8 * LYR;
    constexpr size_t WOFF = WS_W + (size_t)LYR * SZ_WLAYER;
    if (PH_IN(P0 + 0)) {
        LAUNDER_BASES();
        pg8::Gemm g{P_X, P_X, 1 << 30, (const bf16*)(ws + WOFF + OFFW_IN), MP, NZ, 1024, 1024}; pg8::StaticOrder S; S.init(MP, NZ, G, bx);
        pg8::EpiZ E{P_ZQ, P_GB, P_U, P_SSQ, P_SSQX};
        pg8::gemm_phase<pg8::EpiZ, pg8::StaticOrder, true, true>(ldsl, g, S, E);
    }
    PH_SYNC(P0 + 0);
    if (PH_IN(P0 + 1)) {
        { LAUNDER_BASES();
          pg8::Gemm g{P_ZQ, P_ZQ, 1 << 30, (const bf16*)(ws + WOFF + OFFW_Q), MP, 768, 384, 768}; pg8::StaticOrder S; S.init(MP, 768, G, bx);
          pg8::EpiQ E{P_Q, P_SSQ, P_ROPE};
          pg8::gemm_phase<pg8::EpiQ, pg8::StaticOrder, true, true>(ldsl, g, S, E); }
        { LAUNDER_BASES();
          pg8::Gemm g{P_ZQ + 384, P_ZQ + 384, 1 << 30, (const bf16*)(ws + WOFF + OFFW_KV), MP, 1024, 256, 768}; pg8::StaticOrder S; S.init(MP, 1024, G, (bx + 128) % G);
          pg8::EpiKV E{P_KN, P_V, P_SSQ};
          pg8::gemm_phase<pg8::EpiKV, pg8::StaticOrder, true, true>(ldsl, g, S, E); }
        { LAUNDER_BASES(); kr_pass(P_ZQ, P_ROPE, P_KR, gw, NGW, lane); }
    }
    PH_SYNC(P0 + 1);
    if (PH_IN(P0 + 2)) {
        { LAUNDER_BASES(); conv_pass(P_GB, P_U, a.in[9] + (size_t)LYR * 3 * 512, P_AO, gw, NGW, lane); }
        __syncthreads();
        { LAUNDER_BASES();
          for (int i = 0;; ++i) {
            constexpr bool LASTL = (LYR == NLAYER - 1);
            const int id = LASTL ? attn_next_last(i, G, bx) : attn_next(i, G, bx); if (id < 0) break;
            long row0; int L, h, qb, tbeg = 0, nt; float* part = nullptr; unsigned* cnt = nullptr; int piece = 0;
            if (LASTL) {
                if (id < 512) { const int pair = id >> 6; qb = id & 63; h = pair & 3; row0 = ROWS_P + (long)(pair >> 2) * L_S; L = L_S; nt = 257; }
                else { const int e = id - 512, pair = e >> 3; qb = e & 7; h = pair & 3; row0 = (long)(pair >> 2) * L_P; L = L_P; nt = 33; }
            } else if (id < NU_S) { const int pair = id >> 6; qb = id & 63; h = pair & 3; row0 = ROWS_P + (long)(pair >> 2) * L_S; L = L_S; nt = 257; }
            else if (id < NU_S + NU_PC) { const int k = id - NU_S, pair = k / 7; piece = k - pair * 7; qb = 64; h = pair & 3; row0 = ROWS_P + (long)(pair >> 2) * L_S; L = L_S;
                tbeg = 37 * piece; nt = (piece == 6) ? 35 : 37; part = (float*)(ws + WS_PART) + (size_t)pair * att::NPIECE * 16 * 132; cnt = (unsigned*)(ws + WS_CTL) + (LYR * 8 + pair) * 64; }
            else { const int e = id - NU_S - NU_PC, pair = e / 9; qb = e - pair * 9; h = pair & 3; row0 = (long)(pair >> 2) * L_P; L = L_P; nt = 33; }
            att::attn_unit(P_Q, P_KN, P_KR, P_V, P_AO, row0, L, h, qb * 256 + (LASTL ? 16 : 0), (char*)lds, tbeg, nt, part, cnt, piece);
          } }
    }
    PH_SYNC(P0 + 2);
    if (PH_IN(P0 + 3)) {
        LAUNDER_BASES();
        pg8::Gemm g{P_AO, P_AO, 1 << 30, (const bf16*)(ws + WOFF + OFFW_O), MP, 1024, 1024, 1024}; pg8::StaticOrder S; S.init(MP, 1024, G, bx);
        pg8::EpiMix E{P_MIX, P_SSQ};
        pg8::gemm_phase<pg8::EpiMix, pg8::StaticOrder, true, true>(ldsl, g, S, E);
    }
    PH_SYNC(P0 + 3);
    if (PH_IN(P0 + 4)) {
        LAUNDER_BASES(); nr_pass(P_X, P_MIX, P_SSQ, P_SSQX, a.in[11] + LYR * 1024, nullptr, gw, NGW, lane);
    }
    PH_SYNC(P0 + 4);
    if (PH_IN(P0 + 5)) {
        LAUNDER_BASES();
        pg8::Gemm g{P_X, P_X, 1 << 30, (const bf16*)(ws + WOFF + OFFW_GU), MP, 5632, 1024, 1024}; pg8::StaticOrder S; S.init(MP, 5632, G, bx);
        pg8::EpiAct E{P_ACT1, P_ACT2, ACT_SPLIT, P_SSQX};
        pg8::gemm_phase<pg8::EpiAct, pg8::StaticOrder, true, true>(ldsl, g, S, E);
    }
    PH_SYNC(P0 + 5);
    if (PH_IN(P0 + 6)) {
        LAUNDER_BASES();
        pg8::Gemm g{P_ACT1, P_ACT2, ACT_SPLIT, (const bf16*)(ws + WOFF + OFFW_D), MP, 1024, 2816, 2816}; pg8::StaticOrder S; S.init(MP, 1024, G, bx);
        pg8::EpiMix E{P_F, P_SSQ};
        pg8::gemm_phase<pg8::EpiMix, pg8::StaticOrder, true, true>(ldsl, g, S, E);
    }
    PH_SYNC(P0 + 6);
    if (PH_IN(P0 + 7)) {
        LAUNDER_BASES(); nr_pass(P_X, P_F, P_SSQ, P_SSQX, a.in[16] + LYR * 1024, (LYR == NLAYER - 1) ? a.out : nullptr, gw, NGW, lane);
    }
    PH_SYNC(P0 + 7);
}

__global__ void __launch_bounds__(NWAVES * 64, 2) mega_fwd(Args a) {
    extern __shared__ __attribute__((aligned(16))) unsigned char lds[];
    cg::grid_group grid = cg::this_grid();
    const int lo = a.ph_lo, hi = a.ph_hi;
    volatile LAS unsigned* barst = (volatile LAS unsigned*)((LAS unsigned char*)lds + LDS_BARST);
    if (threadIdx.x == 0) { barst[0] = 0u; barst[1] = 0u; }
    __syncthreads();
    if (PH_IN(0)) { LAUNDER_BASES(); p0_prologue(a, (LAS unsigned char*)lds, gw, NGW, wave, lane); }
    XcdBarrier bar; bar.bar = nullptr; bar.x = 0; bar.st = barst;
    if (lo <= 0 && 1 < hi) {
        grid.sync();
        bar = xcd_barrier_post((unsigned*)(a.ws + WS_BAR), barst);
    }
    layer_phases<0>(a, bar, lds, lo, hi);
    layer_phases<1>(a, bar, lds, lo, hi);
}

extern "C" void kernel_launch(void* const* d_in, const int* in_sizes, int n_in, void* d_out, int out_size, void* d_ws, size_t ws_size, hipStream_t stream) {
    static int grid = 0;
    if (grid == 0) {
        if (n_in != 17 || in_sizes[0] != 16 * 2048 * 1024 || in_sizes[1] != 2 * 16384 * 1024 || out_size != 65536 * 1024 || ws_size < WS_END) {
            fprintf(stderr, "kernel_launch: unexpected shapes / workspace (n_in %d, ws %zu, need %zu); nothing launched\n", n_in, ws_size, (size_t)WS_END); grid = -1; return; }
        int dev = 0, cus = 0, per_cu = 0;
        if (hipGetDevice(&dev) != hipSuccess || hipDeviceGetAttribute(&cus, hipDeviceAttributeMultiprocessorCount, dev) != hipSuccess) { grid = -1; return; }
        if (hipFuncSetAttribute((const void*)mega_fwd, hipFuncAttributeMaxDynamicSharedMemorySize, LDS_BYTES) != hipSuccess) { fprintf(stderr, "kernel_launch: hipFuncSetAttribute failed\n"); grid = -1; return; }
        if (hipOccupancyMaxActiveBlocksPerMultiprocessor(&per_cu, (const void*)mega_fwd, NWAVES * 64, LDS_BYTES) != hipSuccess || per_cu < 1) { fprintf(stderr, "kernel_launch: occupancy query failed (%d)\n", per_cu); per_cu = 1; }
        (void)hipGetLastError();
        grid = cus * per_cu;
    }
    if (grid < 0) return;
    Args a{};
    for (int i = 0; i < 17; ++i) a.in[i] = (const float*)d_in[i];
    a.out = (float*)d_out; a.ws = (unsigned char*)d_ws;
    if (N_LAUNCHES == 1) {
        a.ph_lo = 0; a.ph_hi = NPH;
        void* args[] = {&a};
        hipError_t e = hipLaunchCooperativeKernel((void*)mega_fwd, dim3(grid), dim3(NWAVES * 64), args, LDS_BYTES, stream);
        if (e != hipSuccess) fprintf(stderr, "kernel_launch: cooperative launch failed: %s (grid %d)\n", hipGetErrorString(e), grid);
    } else {
        for (int ph = 0; ph < NPH; ++ph) {
            a.ph_lo = ph; a.ph_hi = ph + 1;
            hipLaunchKernelGGL(mega_fwd, dim3(grid), dim3(NWAVES * 64), LDS_BYTES, stream, a);
        }
    }
}
```

```cpp
#include <hip/hip_runtime.h>
#include <hip/hip_cooperative_groups.h>
#include <cstdio>
#include <cstdint>
namespace cg = cooperative_groups;

#ifndef PHM
#define PHM 511
#endif
#ifndef MK_N_LAUNCHES
#define MK_N_LAUNCHES 1
#endif

constexpr int DM = 1024, DFF = 2816, NLAYER = 2;
constexpr int L_P = 2064, L_S = 16400, NSEQ_P = 16, NSEQ_S = 2;
constexpr int ROWS_P = NSEQ_P * L_P;
constexpr int M_REAL = ROWS_P + NSEQ_S * L_S;
constexpr int MP = 66048;
constexpr int NZ = 2304;
constexpr float EPS = 1e-6f;
static_assert(MP % 256 == 0 && MP >= M_REAL, "row padding");

namespace pg8 {
#define PG8_LAS __attribute__((address_space(3)))
typedef unsigned short bf16_t;
typedef short bf16x8 __attribute__((ext_vector_type(8)));
typedef float f32x4 __attribute__((ext_vector_type(4)));
typedef unsigned u32x4 __attribute__((ext_vector_type(4)));
constexpr int BM = 256, BK = 64, HALF = 128, HTB = HALF * BK * 2  , STAGE_BYTES = 8 * HTB, NXCD = 8, WGM = 8;

__host__ __device__ __forceinline__ int lds_byte(int r, int c) { const int st = (r >> 4) * 2 + (c >> 5), rr = r & 15, cc = c & 31, ob = rr * 64 + cc * 2; return st * 1024 + (ob ^ (((ob >> 9) & 1) << 5)); }
__host__ __device__ __forceinline__ void stage_rc(int b, int& R, int& C) { const int st = b / 1024, sb = b % 1024, swz = sb ^ (((sb >> 9) & 1) << 5); R = (st >> 1) * 16 + swz / 64; C = (st & 1) * 32 + (swz % 64) / 2; }
__host__ __device__ __forceinline__ int perm32(int rho) { const int n = rho >> 4, i = rho & 15; return 8 * (i >> 2) + 4 * n + (i & 3); }

struct Unit { int pm, pn; };
struct Gemm { const bf16_t* A; const bf16_t* A2; int pm_split; const bf16_t* Bt; int M, N, K, lda; };

struct StaticOrder {
    int nM, nN, nwg, G, c;
    __host__ __device__ void init(int M, int N, int G_, int c_) { nM = M / BM; nN = N / BM; nwg = nM * nN; G = G_; c = c_; }
    __host__ __device__ bool next(int i, Unit& u) const {
        const long L = (long)i * G + c; if (L >= nwg) return false;
        int wgid = (int)L; { const int q = nwg / NXCD, r = nwg % NXCD, xcd = wgid % NXCD, off = wgid / NXCD; wgid = (xcd < r ? xcd * (q + 1) : r * (q + 1) + (xcd - r) * q) + off; }
        const int nig = WGM * nN, gid = wgid / nig, fm = gid * WGM, gsz = (nM - fm) < WGM ? (nM - fm) : WGM;
        u.pm = fm + ((wgid % nig) % gsz); u.pn = (wgid % nig) / gsz; return true;
    }
    __device__ __forceinline__ void a_ready(const Unit&) const {}
    __device__ __forceinline__ void done(const Unit&) const {}
};


__device__ __forceinline__ unsigned cvt_pk_bf16(float lo, float hi) { unsigned r; asm volatile("v_cvt_pk_bf16_f32 %0, %1, %2" : "=v"(r) : "v"(lo), "v"(hi)); return r; }
__device__ __forceinline__ void st8(bf16_t* p, f32x4 a, f32x4 b) { u32x4 w; w.x = cvt_pk_bf16(a[0], a[1]); w.y = cvt_pk_bf16(a[2], a[3]); w.z = cvt_pk_bf16(b[0], b[1]); w.w = cvt_pk_bf16(b[2], b[3]); *(u32x4*)p = w; }
__device__ __forceinline__ float ssq4(f32x4 a) { return (a[0] * a[0] + a[1] * a[1]) + (a[2] * a[2] + a[3] * a[3]); }
__device__ __forceinline__ float red_fq(float p) { p += __shfl_xor(p, 16); p += __shfl_xor(p, 32); return p; }
__device__ __forceinline__ int row_pos(int r) {
    int pos;
    if (r < ROWS_P) pos = r % L_P; else { pos = (r - ROWS_P) % L_S; }
    return pos;
}

struct EpiZ {
    static constexpr bool PERM = true, AFTER_DRAIN = false;
    bf16_t* ZQ; bf16_t* GB; bf16_t* U; float* SSQ; const float* ssqX;
    __device__ __forceinline__ void operator()(const f32x4 (&acc)[2][2][4][2], const Unit& u, int wr, int wc, int fr, int fq) const {
        asm volatile("" : "+v"(fr), "+v"(fq)); asm volatile("" : "+s"(wr), "+s"(wc));
        const int row0 = u.pm * BM + wr * 64 + fr, pn = u.pn, cw = wc * 32 + fq * 8;
#pragma unroll
        for (int ai = 0; ai < 2; ++ai)
#pragma unroll
            for (int m = 0; m < 4; ++m) {
                const int row = row0 + ai * HALF + m * 16;
                const float s = rsqrtf(ssqX[row] * (1.0f / 1024.0f) + EPS);
                const f32x4 a0 = acc[ai][0][m][0] * s, a1 = acc[ai][0][m][1] * s, b0 = acc[ai][1][m][0] * s, b1 = acc[ai][1][m][1] * s;
                if (pn < 3) {
                    bf16_t* p = ZQ + (size_t)row * 768 + pn * 256 + cw;
                    st8(p, a0, a1); st8(p + HALF, b0, b1);
                    const float pa = red_fq(ssq4(a0) + ssq4(a1)), pb = red_fq(ssq4(b0) + ssq4(b1));
                    if (fq == 0) { SSQ[(size_t)row * 32 + pn * 8 + wc] = pa; SSQ[(size_t)row * 32 + pn * 8 + 4 + wc] = pb; }
                } else if (pn < 5) {
                    bf16_t* p = GB + (size_t)row * 512 + (pn - 3) * 256 + cw;
                    st8(p, a0, a1); st8(p + HALF, b0, b1);
                } else {
                    bf16_t* p = U + (size_t)row * 512 + (pn - 5) * 128 + cw;
                    st8(p, a0 * b0, a1 * b1);
                }
                asm volatile("" ::: "memory");
            }
    }
};
struct EpiQ {
    static constexpr bool PERM = true, AFTER_DRAIN = false;
    bf16_t* Q; const float* SSQ; const float* ROPE;
    __device__ __forceinline__ void operator()(const f32x4 (&acc)[2][2][4][2], const Unit& u, int wr, int wc, int fr, int fq) const {
        asm volatile("" : "+v"(fr), "+v"(fq)); asm volatile("" : "+s"(wr), "+s"(wc));
        const int row0 = u.pm * BM + wr * 64 + fr, pn = u.pn, cw = wc * 32 + fq * 8;
#pragma unroll
        for (int ai = 0; ai < 2; ++ai)
#pragma unroll
            for (int m = 0; m < 4; ++m) {
                const int row = row0 + ai * HALF + m * 16;
                const f32x4* sp = (const f32x4*)(SSQ + (size_t)row * 32);
                const f32x4 s0 = sp[0], s1 = sp[1], s2 = sp[2];
                const float ss = ((s0[0] + s0[1]) + (s0[2] + s0[3])) + ((s1[0] + s1[1]) + (s1[2] + s1[3])) + ((s2[0] + s2[1]) + (s2[2] + s2[3]));
                const float s = rsqrtf(ss * (1.0f / 384.0f) + EPS) * 0.10411754116f;
                const f32x4 a0 = acc[ai][0][m][0] * s, a1 = acc[ai][0][m][1] * s, b0 = acc[ai][1][m][0] * s, b1 = acc[ai][1][m][1] * s;
                bf16_t* qrow = Q + (size_t)row * 768;
                if (pn < 2) { st8(qrow + pn * 256 + cw, a0, a1); st8(qrow + pn * 256 + HALF + cw, b0, b1); }
                else {
                    const int pos = row_pos(row);
                    const f32x4* cp = (const f32x4*)(ROPE + (size_t)pos * 64 + fq * 8);
                    const f32x4 c0 = cp[0], c1 = cp[1], n0 = cp[8], n1 = cp[9];
                    st8(qrow + 512 + cw, a0 * c0 - b0 * n0, a1 * c1 - b1 * n1);
                    st8(qrow + 640 + cw, b0 * c0 + a0 * n0, b1 * c1 + a1 * n1);
                }
                asm volatile("" ::: "memory");
            }
    }
};
struct EpiKV {
    static constexpr bool PERM = true, AFTER_DRAIN = false;
    bf16_t* KN; bf16_t* V; const float* SSQ;
    __device__ __forceinline__ void operator()(const f32x4 (&acc)[2][2][4][2], const Unit& u, int wr, int wc, int fr, int fq) const {
        asm volatile("" : "+v"(fr), "+v"(fq)); asm volatile("" : "+s"(wr), "+s"(wc));
        const int row0 = u.pm * BM + wr * 64 + fr, pn = u.pn, cw = wc * 32 + fq * 8;
        bf16_t* base = (pn < 2) ? KN + pn * 256 : V + (pn - 2) * 256;
#pragma unroll
        for (int ai = 0; ai < 2; ++ai)
#pragma unroll
            for (int m = 0; m < 4; ++m) {
                const int row = row0 + ai * HALF + m * 16;
                const f32x4* sp = (const f32x4*)(SSQ + (size_t)row * 32);
                const f32x4 s0 = sp[3], s1 = sp[4];
                const float ss = ((s0[0] + s0[1]) + (s0[2] + s0[3])) + ((s1[0] + s1[1]) + (s1[2] + s1[3]));
                const float s = rsqrtf(ss * (1.0f / 256.0f) + EPS);
                bf16_t* p = base + (size_t)row * 512 + cw;
                st8(p, acc[ai][0][m][0] * s, acc[ai][0][m][1] * s); st8(p + HALF, acc[ai][1][m][0] * s, acc[ai][1][m][1] * s);
                asm volatile("" ::: "memory");
            }
    }
};
struct EpiMix {
    static constexpr bool PERM = true, AFTER_DRAIN = false;
    bf16_t* OUT; float* SSQ;
    __device__ __forceinline__ void operator()(const f32x4 (&acc)[2][2][4][2], const Unit& u, int wr, int wc, int fr, int fq) const {
        asm volatile("" : "+v"(fr), "+v"(fq)); asm volatile("" : "+s"(wr), "+s"(wc));
        const int row0 = u.pm * BM + wr * 64 + fr, pn = u.pn, cw = wc * 32 + fq * 8;
#pragma unroll
        for (int ai = 0; ai < 2; ++ai)
#pragma unroll
            for (int m = 0; m < 4; ++m) {
                const int row = row0 + ai * HALF + m * 16;
                const f32x4 a0 = acc[ai][0][m][0], a1 = acc[ai][0][m][1], b0 = acc[ai][1][m][0], b1 = acc[ai][1][m][1];
                bf16_t* p = OUT + (size_t)row * 1024 + pn * 256 + cw;
                st8(p, a0, a1); st8(p + HALF, b0, b1);
                const float pa = red_fq(ssq4(a0) + ssq4(a1)), pb = red_fq(ssq4(b0) + ssq4(b1));
                if (fq == 0) { SSQ[(size_t)row * 32 + pn * 8 + wc] = pa; SSQ[(size_t)row * 32 + pn * 8 + 4 + wc] = pb; }
            }
    }
};
struct EpiAct {
    static constexpr bool PERM = true, AFTER_DRAIN = false;
    bf16_t* ACT1; bf16_t* ACT2; int pm_split; const float* ssqX;
    __device__ __forceinline__ void operator()(const f32x4 (&acc)[2][2][4][2], const Unit& u, int wr, int wc, int fr, int fq) const {
        asm volatile("" : "+v"(fr), "+v"(fq)); asm volatile("" : "+s"(wr), "+s"(wc));
        const int rl0 = wr * 64 + fr, pn = u.pn, cw = wc * 32 + fq * 8;
        bf16_t* base = (u.pm < pm_split) ? ACT1 + (size_t)u.pm * BM * 2816 : ACT2 + (size_t)(u.pm - pm_split) * BM * 2816;
#pragma unroll
        for (int ai = 0; ai < 2; ++ai)
#pragma unroll
            for (int m = 0; m < 4; ++m) {
                const int rl = rl0 + ai * HALF + m * 16;
                const float s = rsqrtf(ssqX[u.pm * BM + rl] * (1.0f / 1024.0f) + EPS);
                f32x4 o[2];
#pragma unroll
                for (int n = 0; n < 2; ++n) {
                    const f32x4 g = acc[ai][0][m][n] * s, up = acc[ai][1][m][n] * s;
#pragma unroll
                    for (int j = 0; j < 4; ++j) { const float e = __builtin_amdgcn_exp2f(g[j] * -1.4426950408889634f); o[n][j] = g[j] * __builtin_amdgcn_rcpf(1.0f + e) * up[j]; }
                }
                st8(base + (size_t)rl * 2816 + pn * 128 + cw, o[0], o[1]);
                asm volatile("" ::: "memory");
            }
    }
};

template <class Epi, class Sched, bool ALIGN_EPI = false, bool SP2 = false>
__device__ __forceinline__ void gemm_phase(PG8_LAS unsigned char* lds, const Gemm g, const Sched& S, const Epi& E) {
    int tid = threadIdx.x; asm volatile("" : "+v"(tid));
    const int wid = __builtin_amdgcn_readfirstlane(tid >> 6), lane = tid & 63, wr = wid >> 2, wc = wid & 3, fr = lane & 15, fq = lane >> 4;
    int K = g.K; asm volatile("" : "+s"(K));
    const int nt = K / BK;
    unsigned voffA[2], voffB[2];
#pragma unroll
    for (int i = 0; i < 2; ++i) { int R, C; stage_rc(tid * 16 + i * 8192, R, C); const int Rb = Epi::PERM ? ((R & ~31) + perm32(R & 31)) : R;
        voffA[i] = (unsigned)(R * g.lda + C) * 2u; voffB[i] = (unsigned)(Rb * K + C) * 2u; }
    const size_t kstep = (size_t)(BK * 2);
    const size_t hstepA = (size_t)HALF * g.lda * 2, hstepB = (size_t)HALF * K * 2;
    const size_t tstepA = 2 * hstepA, tstepB = 2 * hstepB;
    const unsigned ldsw = (unsigned)wid * 1024u;
    const int aoff = lds_byte(wr * 64 + fr, fq * 8), boff = lds_byte(wc * 32 + fr, fq * 8);
#define PG8_SA(b, h) (((b) * 2 + (h)) * HTB)
#define PG8_SB(b, h) ((4 + (b) * 2 + (h)) * HTB)
#define PG8_STAGE(bufoff, gbase, voff) do { _Pragma("unroll") for (int _i = 0; _i < 2; ++_i) \
        __builtin_amdgcn_global_load_lds((const unsigned*)((const char*)(gbase) + (voff)[_i]), (PG8_LAS unsigned*)(lds + (bufoff) + ldsw + _i * 8192), 16, 0, 0); } while (0)
#define PG8_LDA(dst, b, h) do { _Pragma("unroll") for (int m = 0; m < 4; ++m) _Pragma("unroll") for (int k = 0; k < 2; ++k) dst[m][k] = *(const PG8_LAS bf16x8*)(lds + PG8_SA(b, h) + aoff + m * 2048 + k * 1024); } while (0)
#define PG8_LDB(dst, b, h) do { _Pragma("unroll") for (int n = 0; n < 2; ++n) _Pragma("unroll") for (int k = 0; k < 2; ++k) dst[n][k] = *(const PG8_LAS bf16x8*)(lds + PG8_SB(b, h) + boff + n * 2048 + k * 1024); } while (0)
#define PG8_MMA(ai, bj, At, Bt) do { __builtin_amdgcn_s_setprio(1); _Pragma("unroll") for (int m = 0; m < 4; ++m) _Pragma("unroll") for (int n = 0; n < 2; ++n) _Pragma("unroll") for (int k = 0; k < 2; ++k) \
        acc[ai][bj][m][n] = __builtin_amdgcn_mfma_f32_16x16x32_bf16(Bt[n][k], At[m][k], acc[ai][bj][m][n], 0, 0, 0); __builtin_amdgcn_s_setprio(0); } while (0)
#define PG8_WAIT_V(n) asm volatile("s_waitcnt vmcnt(" #n ")" ::: "memory")
#define PG8_WAIT_L(n) asm volatile("s_waitcnt lgkmcnt(" #n ")" ::: "memory")
#define PG8_BAR __builtin_amdgcn_s_barrier()
#define PG8_SCHED __builtin_amdgcn_sched_barrier(0)
    Unit cur, nxt; int ui = 0;
    if (!S.next(0, cur)) return;
    f32x4 acc[2][2][4][2];
#pragma unroll
    for (int a = 0; a < 2; ++a)
#pragma unroll
        for (int b = 0; b < 2; ++b)
#pragma unroll
            for (int m = 0; m < 4; ++m)
#pragma unroll
                for (int n = 0; n < 2; ++n) acc[a][b][m][n] = (f32x4){0.f, 0.f, 0.f, 0.f};
    bf16x8 At[4][2], B0[2][2], B1[2][2];
    const char* cA = (cur.pm < g.pm_split) ? (const char*)g.A + (size_t)cur.pm * tstepA : (const char*)g.A2 + (size_t)(cur.pm - g.pm_split) * tstepA; const char* cB = (const char*)g.Bt + (size_t)cur.pn * tstepB;
    S.a_ready(cur);
    if constexpr (SP2) {
        PG8_STAGE(PG8_SB(0, 0), cB, voffB); PG8_STAGE(PG8_SB(0, 1), cB + hstepB, voffB); PG8_STAGE(PG8_SA(0, 0), cA, voffA); PG8_STAGE(PG8_SA(0, 1), cA + hstepA, voffA);
        if (wr == 1) PG8_BAR;
        PG8_WAIT_V(2); PG8_BAR;
        PG8_STAGE(PG8_SB(1, 0), cB + kstep, voffB); PG8_STAGE(PG8_SA(1, 0), cA + kstep, voffA); PG8_STAGE(PG8_SB(1, 1), cB + hstepB + kstep, voffB);
        PG8_WAIT_V(6); PG8_BAR;
    } else {
        PG8_STAGE(PG8_SB(0, 0), cB, voffB); PG8_STAGE(PG8_SA(0, 0), cA, voffA); PG8_STAGE(PG8_SB(0, 1), cB + hstepB, voffB); PG8_STAGE(PG8_SA(0, 1), cA + hstepA, voffA);
        if (wr == 1) PG8_BAR;
        PG8_WAIT_V(4); PG8_BAR;
        PG8_STAGE(PG8_SB(1, 0), cB + kstep, voffB); PG8_STAGE(PG8_SA(1, 0), cA + kstep, voffA); PG8_STAGE(PG8_SB(1, 1), cB + hstepB + kstep, voffB);
        PG8_WAIT_V(6); PG8_BAR;
    }
    for (;;) {
        const bool has_next = S.next(ui + 1, nxt);
        const char* nA = has_next ? ((nxt.pm < g.pm_split) ? (const char*)g.A + (size_t)nxt.pm * tstepA : (const char*)g.A2 + (size_t)(nxt.pm - g.pm_split) * tstepA) : cA; const char* nB = has_next ? (const char*)g.Bt + (size_t)nxt.pn * tstepB : cB;
        for (int t = 0; t < nt; t += 2) {
            const bool last = (t == nt - 2);
            const char* a1 = cA + (size_t)(t + 1) * kstep;
            const char* a2 = last ? nA : cA + (size_t)(t + 2) * kstep; const char* b2 = last ? nB : cB + (size_t)(t + 2) * kstep;
            const char* a3 = a2 + kstep; const char* b3 = b2 + kstep;
            if (last && has_next) S.a_ready(nxt);
            if constexpr (SP2) {
            PG8_LDB(B0, 0, 0); PG8_LDB(B1, 0, 1); PG8_SCHED; PG8_LDA(At, 0, 0); PG8_STAGE(PG8_SA(1, 1), a1 + hstepA, voffA);
            PG8_WAIT_V(8); PG8_WAIT_L(0); PG8_BAR; PG8_MMA(0, 0, At, B0); PG8_MMA(0, 1, At, B1); PG8_BAR; PG8_SCHED;
            PG8_LDA(At, 0, 1); PG8_STAGE(PG8_SB(0, 0), b2, voffB); PG8_STAGE(PG8_SB(0, 1), b2 + hstepB, voffB); PG8_STAGE(PG8_SA(0, 0), a2, voffA);
            PG8_WAIT_V(8); PG8_WAIT_L(0); PG8_BAR; PG8_MMA(1, 0, At, B0); PG8_MMA(1, 1, At, B1); PG8_BAR; PG8_SCHED;
            PG8_LDB(B0, 1, 0); PG8_LDB(B1, 1, 1); PG8_SCHED; PG8_LDA(At, 1, 0); PG8_STAGE(PG8_SA(0, 1), a2 + hstepA, voffA);
            PG8_WAIT_V(8); PG8_WAIT_L(0); PG8_BAR; PG8_MMA(0, 0, At, B0); PG8_MMA(0, 1, At, B1); PG8_BAR; PG8_SCHED;
            PG8_LDA(At, 1, 1); PG8_STAGE(PG8_SB(1, 0), b3, voffB); PG8_STAGE(PG8_SB(1, 1), b3 + hstepB, voffB); PG8_STAGE(PG8_SA(1, 0), a3, voffA);
            PG8_WAIT_V(8); PG8_WAIT_L(0); PG8_BAR; PG8_MMA(1, 0, At, B0); PG8_MMA(1, 1, At, B1); PG8_BAR; PG8_SCHED;
            } else {
            PG8_LDB(B0, 0, 0); PG8_SCHED; PG8_LDA(At, 0, 0); PG8_STAGE(PG8_SA(1, 1), a1 + hstepA, voffA);
            PG8_WAIT_L(8); PG8_BAR; PG8_WAIT_L(0); PG8_MMA(0, 0, At, B0); PG8_BAR; PG8_SCHED;
            PG8_LDB(B1, 0, 1); PG8_STAGE(PG8_SB(0, 0), b2, voffB);
            PG8_BAR; PG8_WAIT_L(0); PG8_MMA(0, 1, At, B1); PG8_BAR;
            PG8_LDA(At, 0, 1); PG8_STAGE(PG8_SA(0, 0), a2, voffA);
            PG8_BAR; PG8_WAIT_L(0); PG8_MMA(1, 0, At, B0); PG8_BAR; PG8_SCHED;
            PG8_STAGE(PG8_SB(0, 1), b2 + hstepB, voffB);
            PG8_WAIT_V(6); PG8_BAR; PG8_MMA(1, 1, At, B1); PG8_BAR;
            PG8_LDB(B0, 1, 0); PG8_SCHED; PG8_LDA(At, 1, 0); PG8_STAGE(PG8_SA(0, 1), a2 + hstepA, voffA);
            PG8_WAIT_L(8); PG8_BAR; PG8_WAIT_L(0); PG8_MMA(0, 0, At, B0); PG8_BAR; PG8_SCHED;
            PG8_LDB(B1, 1, 1); PG8_STAGE(PG8_SB(1, 0), b3, voffB);
            PG8_BAR; PG8_WAIT_L(0); PG8_MMA(0, 1, At, B1); PG8_BAR;
            PG8_LDA(At, 1, 1); PG8_STAGE(PG8_SA(1, 0), a3, voffA);
            PG8_BAR; PG8_WAIT_L(0); PG8_MMA(1, 0, At, B0); PG8_BAR; PG8_SCHED;
            PG8_STAGE(PG8_SB(1, 1), b3 + hstepB, voffB);
            PG8_WAIT_V(6); PG8_BAR; PG8_MMA(1, 1, At, B1); PG8_BAR;
            }
        }
        if constexpr (ALIGN_EPI) { if (wr == 0) PG8_BAR; }
        if constexpr (!Epi::AFTER_DRAIN) { E(acc, cur, wr, wc, fr, fq); S.done(cur); }
        if (!has_next) break;
#pragma unroll
        for (int a = 0; a < 2; ++a)
#pragma unroll
            for (int b = 0; b < 2; ++b)
#pragma unroll
                for (int m = 0; m < 4; ++m)
#pragma unroll
                    for (int n = 0; n < 2; ++n) acc[a][b][m][n] = (f32x4){0.f, 0.f, 0.f, 0.f};
        cur = nxt; cA = nA; cB = nB; ++ui;
        if constexpr (ALIGN_EPI) { if (wr == 1) PG8_BAR; }
    }
    PG8_WAIT_V(0);
    if constexpr (!ALIGN_EPI) { if (wr == 0) PG8_BAR; }
    PG8_BAR;
    if constexpr (Epi::AFTER_DRAIN) { E.fused(acc, cur, wr, wc, fr, fq, lds, wid, lane); S.done(cur); }
#undef PG8_SA
#undef PG8_SB
#undef PG8_STAGE
#undef PG8_LDA
#undef PG8_LDB
#undef PG8_MMA
#undef PG8_WAIT_V
#undef PG8_WAIT_L
#undef PG8_BAR
#undef PG8_SCHED
}
}

namespace att {
typedef unsigned short bf16;
typedef __attribute__((ext_vector_type(8))) short bf16x8;
typedef __attribute__((ext_vector_type(4))) short s16x4;
typedef __attribute__((ext_vector_type(16))) float f32x16;
typedef __attribute__((ext_vector_type(4))) unsigned u32x4;
constexpr int KVBLK = 64;
constexpr float SCALE = 0.07216878364870323f;
constexpr float THR = 8.f;
constexpr int SHM_V = 16384, SHM_KN = 16384, SHM_KR = 8192;
constexpr int OFF_V = 0, OFF_KN = 32768, OFF_KR = 65536, OFF_WS = 81920, OFF_QR = 83968, OFF_FLAG = 83968 + 8 * 4096, ATT_LDS = OFF_FLAG + 16;
constexpr int NPIECE = 7;
#define SBAR() __builtin_amdgcn_sched_barrier(0)
__device__ __forceinline__ int crow(int r, int hi) { return (r & 3) + 8 * (r >> 2) + 4 * hi; }
__device__ __forceinline__ unsigned cvtpk(float lo, float hi) { unsigned r; asm volatile("v_cvt_pk_bf16_f32 %0, %1, %2" : "=v"(r) : "v"(lo), "v"(hi)); return r; }
__device__ __forceinline__ bf16x8 ld8(const bf16* p) { return *reinterpret_cast<const bf16x8*>(p); }

constexpr float THRL = THR * 1.4426950408889634f;
template <bool START>
__device__ __forceinline__ void partialSM(f32x16& p0, f32x16& p1, float& mhat, f32x16& negm, float& alpha) {
  float pmax = p0[0];
#pragma unroll
  for (int r = 1; r < 16; ++r) pmax = fmaxf(pmax, p0[r]);
#pragma unroll
  for (int r = 0; r < 16; ++r) pmax = fmaxf(pmax, p1[r]);
  { auto rr = __builtin_amdgcn_permlane32_swap(__float_as_uint(pmax), __float_as_uint(pmax), false, false);
    pmax = fmaxf(__uint_as_float(rr[0]), __uint_as_float(rr[1])); }
  alpha = 1.f;
  if (START || __builtin_expect(__any(pmax > THRL), 0)) {
    const float dl = START ? pmax : fmaxf(pmax, 0.f);
    mhat += dl;
#pragma unroll
    for (int r = 0; r < 16; ++r) { p0[r] -= dl; p1[r] -= dl; }
#pragma unroll
    for (int r = 0; r < 16; ++r) negm[r] = -mhat;
    asm volatile("" : "+v"(negm));
    if (!START) alpha = __builtin_amdgcn_exp2f(-dl);
  }
#pragma unroll
  for (int r = 0; r < 16; ++r) p0[r] = __builtin_amdgcn_exp2f(p0[r]);
}
__device__ __forceinline__ void finishSM(f32x16& p0, f32x16& p1, float alpha, float& l_reg, bf16x8& pa0, bf16x8& pa1, bf16x8& pa2, bf16x8& pa3) {
#pragma unroll
  for (int r = 0; r < 16; ++r) p1[r] = __builtin_amdgcn_exp2f(p1[r]);
  float ps = 0;
#pragma unroll
  for (int r = 0; r < 16; ++r) ps += p0[r];
#pragma unroll
  for (int r = 0; r < 16; ++r) ps += p1[r];
  { auto rr = __builtin_amdgcn_permlane32_swap(__float_as_uint(ps), __float_as_uint(ps), false, false);
    ps = __uint_as_float(rr[0]) + __uint_as_float(rr[1]); }
  l_reg = l_reg * alpha + ps;
#define PK4(P, BASE, OUT) do { unsigned a0 = cvtpk(P[BASE + 0], P[BASE + 1]), a1 = cvtpk(P[BASE + 2], P[BASE + 3]);   \
    unsigned b0 = cvtpk(P[BASE + 4], P[BASE + 5]), b1 = cvtpk(P[BASE + 6], P[BASE + 7]);                              \
    auto r0 = __builtin_amdgcn_permlane32_swap(a0, b0, false, false); auto r1 = __builtin_amdgcn_permlane32_swap(a1, b1, false, false); \
    u32x4 w = {r0[0], r1[0], r0[1], r1[1]}; OUT = *reinterpret_cast<bf16x8*>(&w); } while (0)
  PK4(p0, 0, pa0); PK4(p0, 8, pa1); PK4(p1, 0, pa2); PK4(p1, 8, pa3);
#undef PK4
}
__device__ __forceinline__ void kmask(f32x16& p0, f32x16& p1, int nv, int hi) {
#pragma unroll
  for (int r = 0; r < 16; ++r) { const int k = crow(r, hi); if (k >= nv) p0[r] = -1e30f; if (k + 32 >= nv) p1[r] = -1e30f; }
}
template <int OFF> __device__ __forceinline__ bf16x8 dsr128(int addr) { bf16x8 r; asm volatile("ds_read_b128 %0, %1 offset:%2" : "=&v"(r) : "v"(addr), "i"(OFF) : "memory"); return r; }
#define LGKM_W2(n, x, y) asm volatile("s_waitcnt lgkmcnt(" #n ")" : "+v"(x), "+v"(y) :: "memory")
#define LGKM_W3(n, x, y, z) asm volatile("s_waitcnt lgkmcnt(" #n ")" : "+v"(x), "+v"(y), "+v"(z) :: "memory")
__device__ __forceinline__ void qkt(f32x16& p0, f32x16& p1, const char* Kn, const char* Kr, const char* Qr, const bf16x8* qr, const f32x16& negm, int lane) {
  const int kn = (int)(uintptr_t)Kn + (lane & 31) * 16 + (lane >> 5) * 1024, kr = (int)(uintptr_t)Kr + (lane & 31) * 16 + (lane >> 5) * 1024, qa = (int)(uintptr_t)Qr + lane * 16;
  bf16x8 a0, a1, b0, b1, qa_, qb_;
#define MM(K0, K1, QQ) do { p0 = __builtin_amdgcn_mfma_f32_32x32x16_bf16(K0, QQ, p0, 0, 0, 0); p1 = __builtin_amdgcn_mfma_f32_32x32x16_bf16(K1, QQ, p1, 0, 0, 0); } while (0)
  a0 = dsr128<0 * 2048>(kn); a1 = dsr128<0 * 2048 + 512>(kn);
  b0 = dsr128<1 * 2048>(kn); b1 = dsr128<1 * 2048 + 512>(kn); LGKM_W2(2, a0, a1);
  p0 = __builtin_amdgcn_mfma_f32_32x32x16_bf16(a0, qr[0], negm, 0, 0, 0); p1 = __builtin_amdgcn_mfma_f32_32x32x16_bf16(a1, qr[0], negm, 0, 0, 0);
  a0 = dsr128<2 * 2048>(kn); a1 = dsr128<2 * 2048 + 512>(kn); LGKM_W2(2, b0, b1); MM(b0, b1, qr[1]);
  b0 = dsr128<3 * 2048>(kn); b1 = dsr128<3 * 2048 + 512>(kn); LGKM_W2(2, a0, a1); MM(a0, a1, qr[2]);
  a0 = dsr128<4 * 2048>(kn); a1 = dsr128<4 * 2048 + 512>(kn); LGKM_W2(2, b0, b1); MM(b0, b1, qr[3]);
  b0 = dsr128<5 * 2048>(kn); b1 = dsr128<5 * 2048 + 512>(kn); LGKM_W2(2, a0, a1); MM(a0, a1, qr[4]);
  a0 = dsr128<6 * 2048>(kn); a1 = dsr128<6 * 2048 + 512>(kn); LGKM_W2(2, b0, b1); MM(b0, b1, qr[5]);
  b0 = dsr128<7 * 2048>(kn); b1 = dsr128<7 * 2048 + 512>(kn); LGKM_W2(2, a0, a1); MM(a0, a1, qr[6]);
  a0 = dsr128<0 * 2048>(kr); a1 = dsr128<0 * 2048 + 512>(kr); qa_ = dsr128<0 * 1024>(qa); LGKM_W2(3, b0, b1); MM(b0, b1, qr[7]);
  b0 = dsr128<1 * 2048>(kr); b1 = dsr128<1 * 2048 + 512>(kr); qb_ = dsr128<1 * 1024>(qa); LGKM_W3(3, a0, a1, qa_); MM(a0, a1, qa_);
  a0 = dsr128<2 * 2048>(kr); a1 = dsr128<2 * 2048 + 512>(kr); qa_ = dsr128<2 * 1024>(qa); LGKM_W3(3, b0, b1, qb_); MM(b0, b1, qb_);
  b0 = dsr128<3 * 2048>(kr); b1 = dsr128<3 * 2048 + 512>(kr); qb_ = dsr128<3 * 1024>(qa); LGKM_W3(3, a0, a1, qa_); MM(a0, a1, qa_);
  LGKM_W3(0, b0, b1, qb_); MM(b0, b1, qb_);
#undef MM
}
__device__ __forceinline__ int v_st(int k, int c) { const int kk = (k & ~0xC) | ((k & 4) << 1) | ((k & 8) >> 1); return ((kk >> 3) * 4 + (c >> 5)) * 512 + ((kk & 7) * 32 + (c & 31)) * 2; }
__device__ __forceinline__ int v_rd_base(int lane) { return ((lane & 3) << 3) | (((lane >> 2) & 3) << 6) | (((lane >> 4) & 1) << 5) | (((lane >> 5) & 1) << 8); }
constexpr int v_rd_off(int d0, int ks, int half) { return d0 * 512 + ks * 4096 + half * 2048; }
template <int OFF> __device__ __forceinline__ s16x4 tr_read(int vb) {
  s16x4 r; asm volatile("ds_read_b64_tr_b16 %0, %1 offset:%2" : "=&v"(r) : "v"(vb), "i"(OFF) : "memory"); return r;
}
struct VF { s16x4 l0, h0, l1, h1, l2, h2, l3, h3; };
template <int D0> __device__ __forceinline__ void pv_rd(VF& f, int vb) {
  f.l0 = tr_read<v_rd_off(D0, 0, 0)>(vb); f.h0 = tr_read<v_rd_off(D0, 0, 1)>(vb); f.l1 = tr_read<v_rd_off(D0, 1, 0)>(vb); f.h1 = tr_read<v_rd_off(D0, 1, 1)>(vb);
  f.l2 = tr_read<v_rd_off(D0, 2, 0)>(vb); f.h2 = tr_read<v_rd_off(D0, 2, 1)>(vb); f.l3 = tr_read<v_rd_off(D0, 3, 0)>(vb); f.h3 = tr_read<v_rd_off(D0, 3, 1)>(vb);
}
#define PV_WAIT(n, f) asm volatile("s_waitcnt lgkmcnt(" #n ")" : "+v"(f.l0), "+v"(f.h0), "+v"(f.l1), "+v"(f.h1), "+v"(f.l2), "+v"(f.h2), "+v"(f.l3), "+v"(f.h3) :: "memory")
__device__ __forceinline__ void pv_mm(f32x16& od, const VF& f, bf16x8 pa0, bf16x8 pa1, bf16x8 pa2, bf16x8 pa3) {
#define PK(L, H) (bf16x8){L[0], L[1], L[2], L[3], H[0], H[1], H[2], H[3]}
  od = __builtin_amdgcn_mfma_f32_32x32x16_bf16(pa0, PK(f.l0, f.h0), od, 0, 0, 0);
  od = __builtin_amdgcn_mfma_f32_32x32x16_bf16(pa1, PK(f.l1, f.h1), od, 0, 0, 0);
  od = __builtin_amdgcn_mfma_f32_32x32x16_bf16(pa2, PK(f.l2, f.h2), od, 0, 0, 0);
  od = __builtin_amdgcn_mfma_f32_32x32x16_bf16(pa3, PK(f.l3, f.h3), od, 0, 0, 0);
#undef PK
}
__device__ __forceinline__ void pv_d0(f32x16* o, int vb, bf16x8 pa0, bf16x8 pa1, bf16x8 pa2, bf16x8 pa3) {
  VF fa, fb;
  pv_rd<0>(fa, vb);
  pv_rd<1>(fb, vb); PV_WAIT(8, fa); pv_mm(o[0], fa, pa0, pa1, pa2, pa3);
  pv_rd<2>(fa, vb); PV_WAIT(8, fb); pv_mm(o[1], fb, pa0, pa1, pa2, pa3);
  pv_rd<3>(fb, vb); PV_WAIT(8, fa); pv_mm(o[2], fa, pa0, pa1, pa2, pa3);
  PV_WAIT(0, fb); pv_mm(o[3], fb, pa0, pa1, pa2, pa3);
}
__device__ __forceinline__ unsigned short f2bf16(float f) { unsigned u = __builtin_bit_cast(unsigned, f); return (unsigned short)((u + 0x7fffu + ((u >> 16) & 1u)) >> 16); }

__device__ __forceinline__ void attn_unit(const bf16* __restrict__ Qg, const bf16* __restrict__ KNg, const bf16* __restrict__ KRg, const bf16* __restrict__ Vg, bf16* __restrict__ AO,
                                          long row0, int L, int h, int q0, char* lds, int tbeg, int NT, float* part, unsigned* cnt, int piece) {
  int tid = threadIdx.x; asm volatile("" : "+v"(tid));
  const int wid = __builtin_amdgcn_readfirstlane(tid >> 6), lane = tid & 63, r32 = lane & 31, hi = lane >> 5;
  char* V_lds = lds + OFF_V; char* KN_lds = lds + OFF_KN; char* KR_lds = lds + OFF_KR;
  float* ws = (float*)(lds + OFF_WS) + wid * 64; float* li_l = ws; float* al_l = ws + 32;
  float mhat = 0.f, l_reg = 0; f32x16 negm = f32x16{}; asm volatile("" : "+v"(negm)); f32x16 o[4] = {}; bf16x8 qr[8]; char* QR_lds = lds + OFF_QR + wid * 4096;
  const bf16* Qw = Qg + (row0 + q0 + wid * 32 + r32) * 768;
#pragma unroll
  for (int d0 = 0; d0 < 8; ++d0) qr[d0] = ld8(Qw + 128 * h + d0 * 16 + hi * 8);
  { const bf16x8 t0 = ld8(Qw + 512 + 32 * h + hi * 8), t1 = ld8(Qw + 512 + 32 * h + 16 + hi * 8), t2 = ld8(Qw + 640 + 32 * h + hi * 8), t3 = ld8(Qw + 640 + 32 * h + 16 + hi * 8);
    *(bf16x8*)(QR_lds + lane * 16) = t0; *(bf16x8*)(QR_lds + lane * 16 + 1024) = t1;
    *(bf16x8*)(QR_lds + lane * 16 + 2048) = t2; *(bf16x8*)(QR_lds + lane * 16 + 3072) = t3; }
  const int sr = tid >> 4, sc = (tid & 15) * 8, vst0 = v_st(sr, sc), vst1 = v_st(32 + sr, sc);
  const int krow = 8 * wid + (lane & 7), kc8 = lane >> 3;
  const int kwoff = (kc8 >> 1) * 2048 + (kc8 & 1) * 1024 + (krow >> 5) * 512 + (krow & 31) * 16;
  const int vb0 = (int)(uintptr_t)V_lds + v_rd_base(lane);
  const bf16* Vh = Vg + row0 * 512 + 128 * h;
  const bf16* Kh = KNg + row0 * 512 + 128 * h;
  const bf16* Rh = KRg + row0 * 64;
  const unsigned kvoff = (unsigned)(sr * 512 + sc), knoff = (unsigned)(krow * 512 + kc8 * 8), kroff = (unsigned)(krow * 64 + kc8 * 8);
  bf16x8 vs0, vs1, ks0, ks1, kr0;
#define KLOAD(k0) do { const bf16* kt_ = Kh + (long)(k0) * 512; const bf16* rt_ = Rh + (long)(k0) * 64; ks0 = ld8(kt_ + knoff); ks1 = ld8(kt_ + 64 + knoff); kr0 = ld8(rt_ + kroff); } while (0)
#define VLOAD(k0) do { const bf16* vt_ = Vh + (long)(k0) * 512; vs0 = ld8(vt_ + kvoff); vs1 = ld8(vt_ + 32 * 512 + kvoff); } while (0)
#define KWRITE(b) do { *(bf16x8*)(KN_lds + (b) * SHM_KN + kwoff) = ks0; *(bf16x8*)(KN_lds + (b) * SHM_KN + 8192 + kwoff) = ks1; *(bf16x8*)(KR_lds + (b) * SHM_KR + kwoff) = kr0; } while (0)
#define VWRITE(b) do { *(bf16x8*)(V_lds + (b) * SHM_V + vst0) = vs0; *(bf16x8*)(V_lds + (b) * SHM_V + vst1) = vs1; } while (0)
#define SWAIT() asm volatile("s_waitcnt vmcnt(0)" ::: "memory")
#define RESC(a) do { if (__any((a) < 1.f)) { if (hi == 0) al_l[r32] = (a); asm volatile("s_waitcnt lgkmcnt(0)" ::: "memory"); \
    _Pragma("unroll") for (int d = 0; d < 4; ++d) _Pragma("unroll") for (int r = 0; r < 16; ++r) o[d][r] *= al_l[crow(r, hi)]; } } while (0)
  f32x16 pA0, pA1, pB0, pB1; float alA, alB; bf16x8 pa0, pa1, pa2, pa3;
  const int NTt = (L + KVBLK - 1) / KVBLK, nv_last = L - (NTt - 1) * KVBLK;
  if (wid >= 4) __builtin_amdgcn_s_setprio(1);
  KLOAD(tbeg * KVBLK); VLOAD(tbeg * KVBLK); SWAIT(); KWRITE(0); VWRITE(0); __syncthreads();
  qkt(pA0, pA1, KN_lds, KR_lds, QR_lds, qr, negm, lane);
  KLOAD((tbeg + 1) * KVBLK);
  partialSM<true>(pA0, pA1, mhat, negm, alA);
  SWAIT(); KWRITE(1); __syncthreads();
  for (int j = 1; j + 1 < NT; j += 2) {
    SBAR(); qkt(pB0, pB1, KN_lds + SHM_KN, KR_lds + SHM_KR, QR_lds, qr, negm, lane);
    finishSM(pA0, pA1, alA, l_reg, pa0, pa1, pa2, pa3); SBAR();
    KLOAD((tbeg + j + 1) * KVBLK); VLOAD((tbeg + j) * KVBLK); SBAR();
    pv_d0(o, vb0, pa0, pa1, pa2, pa3); partialSM<false>(pB0, pB1, mhat, negm, alB);
    RESC(alB);
    SWAIT(); KWRITE(0); VWRITE(1); __syncthreads();
    SBAR(); qkt(pA0, pA1, KN_lds, KR_lds, QR_lds, qr, negm, lane);
    finishSM(pB0, pB1, alB, l_reg, pa0, pa1, pa2, pa3); SBAR();
    const bool more = (j + 2 < NT);
    if (more) KLOAD((tbeg + j + 2) * KVBLK);
    VLOAD((tbeg + j + 1) * KVBLK); SBAR();
    pv_d0(o, vb0 + SHM_V, pa0, pa1, pa2, pa3);
    if (tbeg + j + 1 == NTt - 1) kmask(pA0, pA1, nv_last, hi);
    partialSM<false>(pA0, pA1, mhat, negm, alA);
    RESC(alA);
    SWAIT(); if (more) KWRITE(1); VWRITE(0); __syncthreads();
  }
  finishSM(pA0, pA1, alA, l_reg, pa0, pa1, pa2, pa3); SBAR();
  pv_d0(o, vb0, pa0, pa1, pa2, pa3);
  __builtin_amdgcn_s_setprio(0);
  int lane_e = lane, wid_e = wid, q0_e = q0, h_e = h, L_e = L; long row0_e = row0; char* lds_e = lds;
  asm volatile("" : "+v"(lane_e)); asm volatile("" : "+s"(wid_e), "+s"(q0_e), "+s"(h_e), "+s"(L_e), "+s"(row0_e), "+s"(lds_e));
  if (part != nullptr) {
    __syncthreads();
    if (wid_e == 0) { const int r32e = lane_e & 31, hie = lane_e >> 5;
#pragma unroll
      for (int r = 0; r < 8; ++r) { const int orow = crow(r, hie);
#pragma unroll
        for (int d0 = 0; d0 < 4; ++d0) part[(piece * 16 + orow) * 132 + d0 * 32 + r32e] = o[d0][r]; }
      if (lane_e < 16) { part[(piece * 16 + lane_e) * 132 + 128] = mhat; part[(piece * 16 + lane_e) * 132 + 129] = l_reg; } }
    __threadfence();
    __syncthreads();
    __attribute__((address_space(3))) unsigned* flag = (__attribute__((address_space(3))) unsigned*)(lds_e + OFF_FLAG);
    if (wid_e == 0 && lane_e == 0) { const unsigned old = __hip_atomic_fetch_add(cnt, 1u, __ATOMIC_RELAXED, __HIP_MEMORY_SCOPE_AGENT); *flag = old; }
    __syncthreads();
    const bool last = (*(volatile __attribute__((address_space(3))) unsigned*)flag == (unsigned)(NPIECE - 1));
    if (last) {
      __threadfence();
      const int t = wid_e * 64 + lane_e, row = t >> 5, c4 = (t & 31) * 4;
      float mmax = -3.0e38f;
#pragma unroll
      for (int i = 0; i < NPIECE; ++i) mmax = fmaxf(mmax, (*(part + (i * 16 + row) * 132 + 128)));
      float lsum = 0.f; float a0 = 0.f, a1 = 0.f, a2 = 0.f, a3 = 0.f;
#pragma unroll
      for (int i = 0; i < NPIECE; ++i) { const float* pr = part + (i * 16 + row) * 132;
        const float w = __builtin_amdgcn_exp2f((*(pr + 128)) - mmax); lsum += (*(pr + 129)) * w;
        a0 += (*(pr + c4)) * w; a1 += (*(pr + c4 + 1)) * w; a2 += (*(pr + c4 + 2)) * w; a3 += (*(pr + c4 + 3)) * w; }
      const float rl = 1.0f / lsum;
      const unsigned w0 = (unsigned)f2bf16(a0 * rl) | ((unsigned)f2bf16(a1 * rl) << 16), w1 = (unsigned)f2bf16(a2 * rl) | ((unsigned)f2bf16(a3 * rl) << 16);
      unsigned* dst = (unsigned*)(AO + (row0_e + q0_e + row) * 1024 + 128 * h_e + c4);
      dst[0] = w0; dst[1] = w1;
    }
    __syncthreads();
    return;
  }
  if (hi == 0) li_l[r32] = l_reg; asm volatile("s_waitcnt lgkmcnt(0)" ::: "memory");
  float rli[16];
#pragma unroll
  for (int r = 0; r < 16; ++r) rli[r] = __builtin_amdgcn_rcpf(li_l[crow(r, hi)]);
  __syncthreads();
  __attribute__((address_space(3))) unsigned short* stg = (__attribute__((address_space(3))) unsigned short*)(lds_e + wid_e * 8192);
  { const int r32e = lane_e & 31, hie = lane_e >> 5;
#pragma unroll
  for (int r = 0; r < 16; ++r) { const int orow = crow(r, hie);
#pragma unroll
    for (int d0 = 0; d0 < 4; ++d0) stg[orow * 128 + d0 * 32 + r32e] = f2bf16(o[d0][r] * rli[r]); } }
  asm volatile("s_waitcnt lgkmcnt(0)" ::: "memory");
  const int qw = q0_e + wid_e * 32;
  bf16* AOw = AO + (row0_e + qw) * 1024 + 128 * h_e + (lane_e & 15) * 8;
#pragma unroll
  for (int i = 0; i < 8; ++i) { const int row = i * 4 + (lane_e >> 4); const u32x4 v = *(const __attribute__((address_space(3))) u32x4*)(stg + row * 128 + (lane_e & 15) * 8);
    if (qw + row < L_e) *(u32x4*)(AOw + (long)row * 1024) = v; }
  asm volatile("s_waitcnt lgkmcnt(0)" ::: "memory");
  __syncthreads();
#undef KLOAD
#undef VLOAD
#undef KWRITE
#undef VWRITE
#undef SWAIT
#undef RESC
}
#undef SBAR
}


#define LAS __attribute__((address_space(3)))
typedef unsigned short bf16;
typedef unsigned v4u __attribute__((ext_vector_type(4)));
typedef unsigned v2u __attribute__((ext_vector_type(2)));
typedef float f32x4 __attribute__((ext_vector_type(4)));
constexpr int NWAVES = 8;
constexpr int LDS_BYTES = 147456;
constexpr int NPH = 1 + 8 * NLAYER;
constexpr int N_LAUNCHES = MK_N_LAUNCHES;

constexpr size_t MiB = 1u << 20;
constexpr size_t SZ_WIN = (size_t)NZ * 1024 * 2, SZ_WQ = 768 * 384 * 2, SZ_WKV = 1024 * 256 * 2, SZ_WO = 1024 * 1024 * 2, SZ_WGU = (size_t)5632 * 1024 * 2, SZ_WD = (size_t)1024 * 2816 * 2;
constexpr size_t OFFW_IN = 0, OFFW_Q = OFFW_IN + SZ_WIN, OFFW_KV = OFFW_Q + SZ_WQ, OFFW_O = OFFW_KV + SZ_WKV, OFFW_GU = OFFW_O + SZ_WO, OFFW_D = OFFW_GU + SZ_WGU, SZ_WLAYER = OFFW_D + SZ_WD;
constexpr size_t WS_CTL = 0, WS_BAR = 16384, WS_PART = 65536;
constexpr int LDS_BARST = 147456 - 64;
constexpr size_t WS_W = 1 * MiB, WS_ROPE = 50 * MiB, WS_SSQ = 55 * MiB, WS_SSQX = 63 * MiB + 512 * 1024, WS_X = 64 * MiB;
constexpr size_t WS_GB = 193 * MiB, WS_U = 257 * MiB + 512 * 1024, WS_ZQ = 322 * MiB, WS_AO = 322 * MiB, WS_F = 193 * MiB, WS_ACT1 = 322 * MiB;
constexpr int ACT_SPLIT = 138;
constexpr size_t WS_END = 512 * MiB;
constexpr size_t D_Q = 0, D_KN = (size_t)MP * 768 * 2, D_V = D_KN + (size_t)MP * 512 * 2, D_KR = D_V + (size_t)MP * 512 * 2, D_MIX = 0, D_ACT2 = 0;
static_assert(WS_W + 2 * SZ_WLAYER <= WS_ROPE && WS_ROPE + (size_t)L_S * 64 * 4 <= WS_SSQ && WS_SSQ + (size_t)MP * 32 * 4 <= WS_SSQX && WS_SSQX + (size_t)MP * 4 <= WS_X, "ws fixed region");
static_assert(WS_X + (size_t)MP * 1024 * 2 <= WS_GB && WS_GB + (size_t)MP * 512 * 2 <= WS_U && WS_U + (size_t)MP * 512 * 2 <= WS_ZQ && WS_ZQ + (size_t)MP * 768 * 2 <= WS_END, "ws map 1");
static_assert(WS_AO + (size_t)MP * 1024 * 2 <= WS_END && WS_F + (size_t)MP * 1024 * 2 <= WS_ACT1 && WS_ACT1 + (size_t)ACT_SPLIT * 256 * 2816 * 2 <= WS_END, "ws map 2");
static_assert(D_KR + (size_t)MP * 64 * 2 <= (size_t)256 * MiB && (size_t)(MP / 256 - ACT_SPLIT) * 256 * 2816 * 2 <= (size_t)256 * MiB && (size_t)MP * 1024 * 2 <= (size_t)256 * MiB, "d_out scratch map");

__device__ const double INVF[32] = {1.0, 0.7498942093324559, 0.5623413251903491, 0.4216965034285822, 0.31622776601683794, 0.23713737056616552, 0.1778279410038923, 0.1333521432163324, 0.1, 0.07498942093324558, 0.05623413251903491, 0.042169650342858224, 0.03162277660168379, 0.023713737056616554, 0.01778279410038923, 0.01333521432163324, 0.01, 0.007498942093324558, 0.005623413251903491, 0.004216965034285823, 0.0031622776601683794, 0.0023713737056616554, 0.0017782794100389228, 0.001333521432163324, 0.001, 0.0007498942093324559, 0.0005623413251903491, 0.00042169650342858224, 0.00031622776601683794, 0.00023713737056616554, 0.00017782794100389227, 0.0001333521432163324};

#define LDS_WAIT() asm volatile("s_waitcnt lgkmcnt(0)" ::: "memory")
__device__ __forceinline__ unsigned f2bf(float f) { unsigned u = __builtin_bit_cast(unsigned, f); return (u + 0x7fffu + ((u >> 16) & 1u)) >> 16; }
__device__ __forceinline__ unsigned pk2(float lo, float hi) { return f2bf(lo) | (f2bf(hi) << 16); }
__device__ __forceinline__ float bflo(unsigned w) { return __builtin_bit_cast(float, w << 16); }
__device__ __forceinline__ float bfhi(unsigned w) { return __builtin_bit_cast(float, w & 0xffff0000u); }
__device__ __forceinline__ float wave_sum(float v) {
#pragma unroll
    for (int o = 1; o < 64; o <<= 1) v += __shfl_xor(v, o);
    return v;
}
__device__ __forceinline__ float half_sum32(float v) {
#pragma unroll
    for (int o = 1; o < 32; o <<= 1) v += __shfl_xor(v, o);
    return v;
}

struct Args { const float* in[17]; float* out; unsigned char* ws; int ph_lo, ph_hi; };

__device__ __forceinline__ void p0_transpose_item(const float* W, int Nsrc, int K, int sc0, const float* g, bf16* WT, int dr0, int k0, LAS float* scr, int lane) {
    if (sc0 >= 0) {
#pragma unroll 8
        for (int i = 0; i < 32; ++i) { const int kk = 2 * i + (lane >> 5); const float gv = g ? g[k0 + kk] : 1.0f; scr[kk * 33 + (lane & 31)] = W[(size_t)(k0 + kk) * Nsrc + sc0 + (lane & 31)] * gv; }
    } else {
#pragma unroll 8
        for (int i = 0; i < 32; ++i) { const int kk = 2 * i + (lane >> 5); scr[kk * 33 + (lane & 31)] = 0.0f; }
    }
    LDS_WAIT(); asm volatile("" ::: "memory");
    const int c = lane & 7;
#pragma unroll
    for (int j = 0; j < 4; ++j) { const int n = (lane >> 3) + 8 * j; const LAS float* s = scr + (8 * c) * 33 + n;
        v4u o; o.x = pk2(s[0 * 33], s[1 * 33]); o.y = pk2(s[2 * 33], s[3 * 33]); o.z = pk2(s[4 * 33], s[5 * 33]); o.w = pk2(s[6 * 33], s[7 * 33]);
        *(v4u*)(WT + (size_t)(dr0 + n) * K + k0 + 8 * c) = o; }
    LDS_WAIT(); asm volatile("" ::: "memory");
}

__device__ __forceinline__ void p0_prologue(const Args& a, LAS unsigned char* lds, int gw, int NGW, int wave, int lane) {
    LAS float* scr = (LAS float*)(lds + wave * 16384);
    unsigned char* ws = a.ws;
    if (gw == 0 && lane < 2 * 8) ((unsigned*)(ws + WS_CTL))[lane * 64] = 0u;
    if (gw < NWAVES) { for (int i = gw * 64 + lane; i < 3456; i += NWAVES * 64) ((unsigned*)(ws + WS_BAR))[i] = 0u; }
    constexpr int I0 = 16 * 72, I1 = 6 * 24, I2 = 4 * 32, I3 = 16 * 32, I4 = 16 * 176, I5 = 44 * 32, IL = I0 + I1 + I2 + I3 + I4 + I5;
    for (int it = gw; it < NLAYER * IL; it += NGW) {
        const int l = it / IL; int r = it % IL;
        bf16* wl = (bf16*)(ws + WS_W + (size_t)l * SZ_WLAYER);
        if (r < I0) {
            const int kb = r / 72, nb = r % 72, n0 = nb * 32; int sc;
            if (n0 < 704) sc = n0; else if (n0 < 768) sc = -1; else if (n0 < 1280) sc = n0 - 64;
            else { const int t = (n0 - 1280) >> 8, w = (n0 - 1280) & 255; sc = (w < 128) ? 1216 + 128 * t + w : 1728 + 128 * t + (w - 128); }
            p0_transpose_item(a.in[4] + (size_t)l * 1024 * 2240, 2240, 1024, sc, a.in[3] + l * 1024, (bf16*)((unsigned char*)wl + OFFW_IN), n0, kb * 64, scr, lane); continue; }
        r -= I0;
        if (r < I1) {
            const int kb = r / 24, nb = r % 24, n0 = nb * 32; int sc;
            if (n0 < 512) sc = 192 * (n0 >> 7) + (n0 & 127); else if (n0 < 640) sc = 192 * ((n0 - 512) >> 5) + 128; else sc = 192 * ((n0 - 640) >> 5) + 160;
            p0_transpose_item(a.in[6] + (size_t)l * 384 * 768, 768, 384, sc, a.in[5] + l * 384, (bf16*)((unsigned char*)wl + OFFW_Q), n0, kb * 64, scr, lane); continue; }
        r -= I1;
        if (r < I2) {
            const int kb = r / 32, nb = r % 32, n0 = nb * 32; int sc;
            if (n0 < 512) sc = 256 * (n0 >> 7) + (n0 & 127); else sc = 256 * ((n0 - 512) >> 7) + 128 + ((n0 - 512) & 127);
            p0_transpose_item(a.in[8] + (size_t)l * 256 * 1024, 1024, 256, sc, a.in[7] + l * 256, (bf16*)((unsigned char*)wl + OFFW_KV), n0, kb * 64, scr, lane); continue; }
        r -= I2;
        if (r < I3) {
            const int kb = r / 32, nb = r % 32, n0 = nb * 32;
            p0_transpose_item(a.in[10] + (size_t)l * 1024 * 1024, 1024, 1024, n0, nullptr, (bf16*)((unsigned char*)wl + OFFW_O), n0, kb * 64, scr, lane); continue; }
        r -= I3;
        if (r < I4) {
            const int kb = r / 176, nb = r % 176, n0 = nb * 32; const int t = n0 >> 8, w = n0 & 255;
            const float* src = (w < 128) ? a.in[13] : a.in[14]; const int sc = 128 * t + (w & 127);
            p0_transpose_item(src + (size_t)l * 1024 * 2816, 2816, 1024, sc, a.in[12] + l * 1024, (bf16*)((unsigned char*)wl + OFFW_GU), n0, kb * 64, scr, lane); continue; }
        r -= I4;
        {
            const int kb = r / 32, nb = r % 32, n0 = nb * 32;
            p0_transpose_item(a.in[15] + (size_t)l * 2816 * 1024, 1024, 2816, n0, nullptr, (bf16*)((unsigned char*)wl + OFFW_D), n0, kb * 64, scr, lane); }
    }
    {
        float* rope = (float*)(ws + WS_ROPE);
        const int gt = gw * 64 + lane, NGT = NGW * 64;
        for (int idx = gt; idx < L_S * 32; idx += NGT) {
            const int pos = idx >> 5, i = idx & 31;
            const double ang = (double)pos * INVF[i];
            const double TWO_PI = 6.283185307179586476925286766559;
            const double kq = __builtin_rint(ang * (1.0 / TWO_PI));
            const double rr = __builtin_fma(-kq, TWO_PI, ang);
            const double x = rr * 0.125, x2 = x * x;
            double sn = x * (1.0 + x2 * (-1.0 / 6.0 + x2 * (1.0 / 120.0 + x2 * (-1.0 / 5040.0 + x2 * (1.0 / 362880.0 + x2 * (-1.0 / 39916800.0))))));
            double cs = 1.0 + x2 * (-0.5 + x2 * (1.0 / 24.0 + x2 * (-1.0 / 720.0 + x2 * (1.0 / 40320.0 + x2 * (-1.0 / 3628800.0 + x2 * (1.0 / 479001600.0))))));
#pragma unroll
            for (int d = 0; d < 3; ++d) { const double s2 = 2.0 * sn * cs, c2 = cs * cs - sn * sn; sn = s2; cs = c2; }
            rope[(size_t)pos * 64 + i] = (float)cs; rope[(size_t)pos * 64 + 32 + i] = (float)sn;
        }
    }
    {
        bf16* X = (bf16*)(ws + WS_X); float* ssqX = (float*)(ws + WS_SSQX);
        for (int r = gw; r < MP; r += NGW) {
            v2u* o8 = (v2u*)(X + (size_t)r * 1024) + lane;
            if (r >= M_REAL) {
#pragma unroll
                for (int j = 0; j < 4; ++j) o8[64 * j] = (v2u){0u, 0u};
                if (lane == 0) ssqX[r] = 0.0f;
                continue;
            }
            const float* src;
            if (r < ROWS_P) { const int s = r / L_P, pos = r - s * L_P; src = (pos < 16) ? a.in[2] + pos * 1024 : a.in[0] + ((size_t)s * 2048 + (pos - 16)) * 1024; }
            else { const int q = r - ROWS_P, s = q / L_S, pos = q - s * L_S; src = (pos < 16) ? a.in[2] + pos * 1024 : a.in[1] + ((size_t)s * 16384 + (pos - 16)) * 1024; }
            const f32x4* xr = (const f32x4*)src + lane;
            f32x4 v[4]; float s2 = 0.f;
#pragma unroll
            for (int j = 0; j < 4; ++j) { v[j] = xr[64 * j]; s2 += (v[j].x * v[j].x + v[j].y * v[j].y) + (v[j].z * v[j].z + v[j].w * v[j].w); }
            s2 = wave_sum(s2);
#pragma unroll
            for (int j = 0; j < 4; ++j) o8[64 * j] = (v2u){pk2(v[j].x, v[j].y), pk2(v[j].z, v[j].w)};
            if (lane == 0) ssqX[r] = s2;
        }
    }
}

__device__ __forceinline__ void kr_pass(const bf16* ZQ, const float* rope, bf16* KR, int gw, int NGW, int lane) {
    const int i = lane & 31;
    for (int r = gw; r < MP; r += NGW) {
        const int pos = pg8::row_pos(r);
        const bf16* z = ZQ + (size_t)r * 768 + 640;
        const float x1 = bflo((unsigned)z[i]), x2 = bflo((unsigned)z[32 + i]);
        const float c = rope[(size_t)pos * 64 + i], s = rope[(size_t)pos * 64 + 32 + i];
        const float y = (lane < 32) ? (x1 * c - x2 * s) : (x2 * c + x1 * s);
        KR[(size_t)r * 64 + lane] = (bf16)f2bf(y);
    }
}
__device__ __forceinline__ void conv_pass(const bf16* GB, const bf16* U, const float* cw  , bf16* AO, int gw, int NGW, int lane) {
    const int c0 = lane * 8;
    f32x4 w[3][2];
#pragma unroll
    for (int k = 0; k < 3; ++k) { w[k][0] = *(const f32x4*)(cw + k * 512 + c0); w[k][1] = *(const f32x4*)(cw + k * 512 + c0 + 4); }
    for (int r = gw; r < MP; r += NGW) {
        v4u* dst = (v4u*)(AO + (size_t)r * 1024 + 512 + c0);
        if (r >= M_REAL) { *dst = (v4u){0u, 0u, 0u, 0u}; *(v4u*)(AO + (size_t)r * 1024 + c0) = (v4u){0u, 0u, 0u, 0u}; continue; }
        int pos, L;
        if (r < ROWS_P) { pos = r % L_P; L = L_P; } else { pos = (r - ROWS_P) % L_S; L = L_S; }
        const v4u g = *(const v4u*)(GB + (size_t)r * 512 + c0);
        const v4u u1 = *(const v4u*)(U + (size_t)r * 512 + c0);
        v4u u0 = (v4u){0u, 0u, 0u, 0u}, u2 = (v4u){0u, 0u, 0u, 0u};
        if (pos > 0) u0 = *(const v4u*)(U + (size_t)(r - 1) * 512 + c0);
        if (pos < L - 1) u2 = *(const v4u*)(U + (size_t)(r + 1) * 512 + c0);
        v4u o;
#pragma unroll
        for (int q = 0; q < 4; ++q) {
            const int h = q >> 1, e = (q & 1) * 2;
            const float lo = bflo(g[q]) * (w[0][h][e] * bflo(u0[q]) + w[1][h][e] * bflo(u1[q]) + w[2][h][e] * bflo(u2[q]));
            const float hi = bfhi(g[q]) * (w[0][h][e + 1] * bfhi(u0[q]) + w[1][h][e + 1] * bfhi(u1[q]) + w[2][h][e + 1] * bfhi(u2[q]));
            o[q] = pk2(lo, hi);
        }
        *dst = o;
    }
}
__device__ __forceinline__ void nr_pass(bf16* X, const bf16* Y, const float* SSQ, float* ssqX, const float* g, float* out  , int gw, int NGW, int lane) {
    f32x4 gv[4];
#pragma unroll
    for (int j = 0; j < 4; ++j) gv[j] = *((const f32x4*)g + lane + 64 * j);
    for (int r = gw; r < M_REAL; r += NGW) {
        const float part = SSQ[(size_t)r * 32 + (lane & 31)];
        const float s = rsqrtf(half_sum32(part) * (1.0f / 1024.0f) + EPS);
        v2u* x8 = (v2u*)(X + (size_t)r * 1024) + lane; const v2u* y8 = (const v2u*)(Y + (size_t)r * 1024) + lane;
        f32x4 v[4]; float s2 = 0.f;
#pragma unroll
        for (int j = 0; j < 4; ++j) { const v2u xv = x8[64 * j], yv = y8[64 * j];
            v[j].x = bflo(xv.x) + bflo(yv.x) * s * gv[j].x; v[j].y = bfhi(xv.x) + bfhi(yv.x) * s * gv[j].y;
            v[j].z = bflo(xv.y) + bflo(yv.y) * s * gv[j].z; v[j].w = bfhi(xv.y) + bfhi(yv.y) * s * gv[j].w;
            s2 += (v[j].x * v[j].x + v[j].y * v[j].y) + (v[j].z * v[j].z + v[j].w * v[j].w); }
        if (out == nullptr) {
            s2 = wave_sum(s2);
#pragma unroll
            for (int j = 0; j < 4; ++j) x8[64 * j] = (v2u){pk2(v[j].x, v[j].y), pk2(v[j].z, v[j].w)};
            if (lane == 0) ssqX[r] = s2;
        } else {
            int pos; size_t orow;
            if (r < ROWS_P) { const int sq = r / L_P; pos = r - sq * L_P; orow = (size_t)sq * 2048 + (pos - 16); }
            else { const int q = r - ROWS_P, sq = q / L_S; pos = q - sq * L_S; orow = (size_t)NSEQ_P * 2048 + (size_t)sq * 16384 + (pos - 16); }
            if (pos >= 16) { f32x4* o = (f32x4*)(out + orow * 1024) + lane;
#pragma unroll
                for (int j = 0; j < 4; ++j) o[64 * j] = v[j]; }
        }
    }
}

constexpr int NU_S = 512, NU_PC = 56, NU_P = 576, NU = NU_S + NU_PC + NU_P;
__device__ __forceinline__ int attn_next(int i, int G, int bx) {
    if (G == 256) {
        const int vcu = (bx & 7) * 32 + (bx >> 3), x = vcu >> 5, c = vcu & 31;
        if (i == 0) return 64 * x + c;
        if (i == 1) return 64 * x + 32 + c;
        const int e = c + 32 * (i - 2);
        if (e >= 79) return -1;
        if (e < 15) return NU_S + NU_PC + 72 * x + e;
        if (e < 22) return NU_S + 7 * x + (e - 15);
        return NU_S + NU_PC + 72 * x + (e - 7);
    }
    const int id = i * G + bx; return (id < NU) ? id : -1;
}

#define XB_TMO      128
#define XB_XCNT(j)  (256  + 64 * (j))
#define XB_XSUB(j)  (1280 + 64 * (j))
#define XB_XGEN(j)  (2304 + 64 * (j))
#define XB_TOP      3328
#define XB_TOPGEN   3392
#define XCD_BAR_WORDS 3456
#define XB_SPIN_CAP (1u << 18)

__device__ __forceinline__ unsigned xb_ld(unsigned* p)              { return __hip_atomic_load(p, __ATOMIC_RELAXED, __HIP_MEMORY_SCOPE_AGENT); }
__device__ __forceinline__ unsigned xb_add(unsigned* p, unsigned v) { return __hip_atomic_fetch_add(p, v, __ATOMIC_RELAXED, __HIP_MEMORY_SCOPE_AGENT); }
__device__ __forceinline__ unsigned xb_xcc_id() { return (unsigned)__builtin_amdgcn_s_getreg((3 << 11) | 20) & 0xFu; }
#define XB_SPIN(cond, bar) do { unsigned _sp = 0; while (cond) { __builtin_amdgcn_s_sleep(1); \
    if ((++_sp & 255u) == 0u) { if (xb_ld(&(bar)[XB_TMO])) break; if (_sp > XB_SPIN_CAP) { atomicAdd(&(bar)[XB_TMO], 1u); break; } } } } while (0)

struct XcdBarrier {
    unsigned* bar; unsigned x;
    volatile LAS unsigned* st;
};

__device__ __forceinline__ XcdBarrier xcd_barrier_post(unsigned* bar, volatile LAS unsigned* st) {
    XcdBarrier b; b.bar = bar; b.x = xb_xcc_id(); b.st = st;
    if (threadIdx.x == 0) (void)xb_add(&bar[XB_XCNT(b.x)], 1u);
    return b;
}
__device__ __forceinline__ void xcd_barrier_complete(unsigned* bar, unsigned x, unsigned& nloc, unsigned& nx) {
    const unsigned G = gridDim.x * gridDim.y * gridDim.z;
    unsigned sum, cnt, mine, sp = 0u;
    for (;;) {
        sum = 0u; cnt = 0u; mine = 0u;
#pragma unroll
        for (unsigned j = 0; j < 16; ++j) { const unsigned c = xb_ld(&bar[XB_XCNT(j)]); sum += c; cnt += (c > 0u) ? 1u : 0u; mine = (j == x) ? c : mine; }
        if (sum == G) break;
        __builtin_amdgcn_s_sleep(1);
        if ((++sp & 255u) == 0u) { if (xb_ld(&bar[XB_TMO])) break; if (sp > XB_SPIN_CAP) { atomicAdd(&bar[XB_TMO], 1u); break; } }
    }
    nloc = mine > 0u ? mine : 1u; nx = cnt > 0u ? cnt : 1u;
}

__device__ __forceinline__ void xcd_barrier(const XcdBarrier& b) {
    asm volatile("s_waitcnt vmcnt(0)" ::: "memory");
    __syncthreads();
    if (threadIdx.x == 0) {
        unsigned* bar = b.bar;
        __builtin_amdgcn_s_waitcnt(0);
        unsigned nloc = b.st[0], nx = b.st[1];
        if (nloc == 0u) { xcd_barrier_complete(bar, b.x, nloc, nx); b.st[0] = nloc; b.st[1] = nx; }
        const unsigned old = xb_add(&bar[XB_XSUB(b.x)], 1u);
        const unsigned gen = old / nloc;
        if (old + 1u == (gen + 1u) * nloc) {
            __builtin_amdgcn_fence(__ATOMIC_RELEASE, "agent");
            asm volatile("s_waitcnt vmcnt(0)" ::: "memory");
            const unsigned og = xb_add(&bar[XB_TOP], 1u);
            const unsigned tg = og / nx;
            if (og + 1u == (tg + 1u) * nx) xb_add(&bar[XB_TOPGEN], 1u);
            else XB_SPIN(xb_ld(&bar[XB_TOPGEN]) == tg, bar);
            __builtin_amdgcn_fence(__ATOMIC_ACQUIRE, "agent");
            xb_add(&bar[XB_XGEN(b.x)], 1u);
            asm volatile("s_waitcnt vmcnt(0)" ::: "memory");
        } else {
            XB_SPIN(xb_ld(&bar[XB_XGEN(b.x)]) == gen, bar);
            __builtin_amdgcn_fence(__ATOMIC_ACQUIRE, "agent");
            asm volatile("s_waitcnt vmcnt(0)" ::: "memory");
        }
    }
    __syncthreads();
}

__device__ __forceinline__ int attn_next_last(int i, int G, int bx) {
    if (G == 256) {
        const int vcu = (bx & 7) * 32 + (bx >> 3), x = vcu >> 5, c = vcu & 31;
        if (i == 0) return 64 * x + c;
        if (i == 1) return 64 * x + 32 + c;
        if (i < 4) return 512 + 64 * x + c + 32 * (i - 2);
        return -1;
    }
    const int id = i * G + bx; return (id < 1024) ? id : -1;
}

#define GAS __attribute__((address_space(1)))
#define LAUNDER_BASES() GAS unsigned char* wsg_ = (GAS unsigned char*)a.ws; GAS unsigned char* dsg_ = (GAS unsigned char*)a.out; asm volatile("" : "+s"(wsg_), "+s"(dsg_)); \
    unsigned char* ws = (unsigned char*)wsg_; unsigned char* dsc = (unsigned char*)dsg_;     \
    int lane = threadIdx.x & 63, wave = __builtin_amdgcn_readfirstlane(threadIdx.x >> 6), G = gridDim.x, bx = blockIdx.x; \
    asm volatile("" : "+v"(lane)); asm volatile("" : "+s"(wave), "+s"(G), "+s"(bx)); \
    const int gw = bx * NWAVES + wave, NGW = G * NWAVES; (void)gw; (void)NGW; (void)lane; (void)dsc
#define P_X ((bf16*)(ws + WS_X))
#define P_GB ((bf16*)(ws + WS_GB))
#define P_U ((bf16*)(ws + WS_U))
#define P_ZQ ((bf16*)(ws + WS_ZQ))
#define P_AO ((bf16*)(ws + WS_AO))
#define P_F ((bf16*)(ws + WS_F))
#define P_ACT1 ((bf16*)(ws + WS_ACT1))
#define P_ACT2 ((bf16*)(dsc + D_ACT2))
#define P_Q ((bf16*)(dsc + D_Q))
#define P_KN ((bf16*)(dsc + D_KN))
#define P_V ((bf16*)(dsc + D_V))
#define P_KR ((bf16*)(dsc + D_KR))
#define P_MIX ((bf16*)(dsc + D_MIX))
#define P_SSQ ((float*)(ws + WS_SSQ))
#define P_SSQX ((float*)(ws + WS_SSQX))
#define P_ROPE ((const float*)(ws + WS_ROPE))
#define PH_IN(p) (lo <= (p) && (p) < hi && ((PHM >> ((p) == 0 ? 0 : (((p) - 1) & 7) + 1)) & 1))
#define PH_SYNC(p) do { if (lo <= (p) && (p) + 1 < hi) xcd_barrier(bar); } while (0)

template <int LYR>
__device__ __forceinline__ void layer_phases(const Args& a, const XcdBarrier& bar, unsigned char* lds, int lo, int hi) {
    LAS unsigned char* ldsl = (LAS unsigned char*)lds;
    constexpr int P0 = 1 + 8 * LYR;
    constexpr size_t WOFF = WS_W + (size_t)LYR * SZ_WLAYER;
    if (PH_IN(P0 + 0)) {
        LAUNDER_BASES();
        pg8::Gemm g{P_X, P_X, 1 << 30, (const bf16*)(ws + WOFF + OFFW_IN), MP, NZ, 1024, 1024}; pg8::StaticOrder S; S.init(MP, NZ, G, bx);
        pg8::EpiZ E{P_ZQ, P_GB, P_U, P_SSQ, P_SSQX};
        pg8::gemm_phase<pg8::EpiZ, pg8::StaticOrder, true, true>(ldsl, g, S, E);
    }
    PH_SYNC(P0 + 0);
    if (PH_IN(P0 + 1)) {
        { LAUNDER_BASES();
          pg8::Gemm g{P_ZQ, P_ZQ, 1 << 30, (const bf16*)(ws + WOFF + OFFW_Q), MP, 768, 384, 768}; pg8::StaticOrder S; S.init(MP, 768, G, bx);
          pg8::EpiQ E{P_Q, P_SSQ, P_ROPE};
          pg8::gemm_phase<pg8::EpiQ, pg8::StaticOrder, true, true>(ldsl, g, S, E); }
        { LAUNDER_BASES();
          pg8::Gemm g{P_ZQ + 384, P_ZQ + 384, 1 << 30, (const bf16*)(ws + WOFF + OFFW_KV), MP, 1024, 256, 768}; pg8::StaticOrder S; S.init(MP, 1024, G, (bx + 128) % G);
          pg8::EpiKV E{P_KN, P_V, P_SSQ};
          pg8::gemm_phase<pg8::EpiKV, pg8::StaticOrder, true, true>(ldsl, g, S, E); }
        { LAUNDER_BASES(); kr_pass(P_ZQ, P_ROPE, P_KR, gw, NGW, lane); }
    }
    PH_SYNC(P0 + 1);
    if (PH_IN(P0 + 2)) {
        { LAUNDER_BASES(); conv_pass(P_GB, P_U, a.in[9] + (size_t)LYR * 3 * 512, P_AO, gw, NGW, lane); }
        __syncthreads();
        { LAUNDER_BASES();
          for (int i = 0;; ++i) {
            constexpr bool LASTL = (LYR == NLAYER - 1);
            const int id = LASTL ? attn_next_last(i, G, bx) : attn_next(i, G, bx); if (id < 0) break;
            long row0; int L, h, qb, tbeg = 0, nt; float* part = nullptr; unsigned* cnt = nullptr; int piece = 0;
            if (LASTL) {
                if (id < 512) { const int pair = id >> 6; qb = id & 63; h = pair & 3; row0 = ROWS_P + (long)(pair >> 2) * L_S; L = L_S; nt = 257; }
                else { const int e = id - 512, pair = e >> 3; qb = e & 7; h = pair & 3; row0 = (long)(pair >> 2) * L_P; L = L_P; nt = 33; }
            } else if (id < NU_S) { const int pair = id >> 6; qb = id & 63; h = pair & 3; row0 = ROWS_P + (long)(pair >> 2) * L_S; L = L_S; nt = 257; }
            else if (id < NU_S + NU_PC) { const int k = id - NU_S, pair = k / 7; piece = k - pair * 7; qb = 64; h = pair & 3; row0 = ROWS_P + (long)(pair >> 2) * L_S; L = L_S;
                tbeg = 37 * piece; nt = (piece == 6) ? 35 : 37; part = (float*)(ws + WS_PART) + (size_t)pair * att::NPIECE * 16 * 132; cnt = (unsigned*)(ws + WS_CTL) + (LYR * 8 + pair) * 64; }
            else { const int e = id - NU_S - NU_PC, pair = e / 9; qb = e - pair * 9; h = pair & 3; row0 = (long)(pair >> 2) * L_P; L = L_P; nt = 33; }
            att::attn_unit(P_Q, P_KN, P_KR, P_V, P_AO, row0, L, h, qb * 256 + (LASTL ? 16 : 0), (char*)lds, tbeg, nt, part, cnt, piece);
          } }
    }
    PH_SYNC(P0 + 2);
    if (PH_IN(P0 + 3)) {
        LAUNDER_BASES();
        pg8::Gemm g{P_AO, P_AO, 1 << 30, (const bf16*)(ws + WOFF + OFFW_O), MP, 1024, 1024, 1024}; pg8::StaticOrder S; S.init(MP, 1024, G, bx);
        pg8::EpiMix E{P_MIX, P_SSQ};
        pg8::gemm_phase<pg8::EpiMix, pg8::StaticOrder, true, true>(ldsl, g, S, E);
    }
    PH_SYNC(P0 + 3);
    if (PH_IN(P0 + 4)) {
        LAUNDER_BASES(); nr_pass(P_X, P_MIX, P_SSQ, P_SSQX, a.in[11] + LYR * 1024, nullptr, gw, NGW, lane);
    }
    PH_SYNC(P0 + 4);
    if (PH_IN(P0 + 5)) {
        LAUNDER_BASES();
        pg8::Gemm g{P_X, P_X, 1 << 30, (const bf16*)(ws + WOFF + OFFW_GU), MP, 5632, 1024, 1024}; pg8::StaticOrder S; S.init(MP, 5632, G, bx);
        pg8::EpiAct E{P_ACT1, P_ACT2, ACT_SPLIT, P_SSQX};
        pg8::gemm_phase<pg8::EpiAct, pg8::StaticOrder, true, true>(ldsl, g, S, E);
    }
    PH_SYNC(P0 + 5);
    if (PH_IN(P0 + 6)) {
        LAUNDER_BASES();
        pg8::Gemm g{P_ACT1, P_ACT2, ACT_SPLIT, (const bf16*)(ws + WOFF + OFFW_D), MP, 1024, 2816, 2816}; pg8::StaticOrder S; S.init(MP, 1024, G, bx);
        pg8::EpiMix E{P_F, P_SSQ};
        pg8::gemm_phase<pg8::EpiMix, pg8::StaticOrder, true, true>(ldsl, g, S, E);
    }
    PH_SYNC(P0 + 6);
    if (PH_IN(P0 + 7)) {
        LAUNDER_BASES(); nr_pass(P_X, P_F, P_SSQ, P_SSQX, a.in[16] + LYR * 1024, (LYR == NLAYER - 1) ? a.out : nullptr, gw, NGW, lane);
    }
    PH_SYNC(P0 + 7);
}

__global__ void __launch_bounds__(NWAVES * 64, 2) mega_fwd(Args a) {
    extern __shared__ __attribute__((aligned(16))) unsigned char lds[];
    cg::grid_group grid = cg::this_grid();
    const int lo = a.ph_lo, hi = a.ph_hi;
    volatile LAS unsigned* barst = (volatile LAS unsigned*)((LAS unsigned char*)lds + LDS_BARST);
    if (threadIdx.x == 0) { barst[0] = 0u; barst[1] = 0u; }
    __syncthreads();
    if (PH_IN(0)) { LAUNDER_BASES(); p0_prologue(a, (LAS unsigned char*)lds, gw, NGW, wave, lane); }
    XcdBarrier bar; bar.bar = nullptr; bar.x = 0; bar.st = barst;
    if (lo <= 0 && 1 < hi) {
        grid.sync();
        bar = xcd_barrier_post((unsigned*)(a.ws + WS_BAR), barst);
    }
    layer_phases<0>(a, bar, lds, lo, hi);
    layer_phases<1>(a, bar, lds, lo, hi);
}

extern "C" void kernel_launch(void* const* d_in, const int* in_sizes, int n_in, void* d_out, int out_size, void* d_ws, size_t ws_size, hipStream_t stream) {
    static int grid = 0;
    if (grid == 0) {
        if (n_in != 17 || in_sizes[0] != 16 * 2048 * 1024 || in_sizes[1] != 2 * 16384 * 1024 || out_size != 65536 * 1024 || ws_size < WS_END) {
            fprintf(stderr, "kernel_launch: unexpected shapes / workspace (n_in %d, ws %zu, need %zu); nothing launched\n", n_in, ws_size, (size_t)WS_END); grid = -1; return; }
        int dev = 0, cus = 0, per_cu = 0;
        if (hipGetDevice(&dev) != hipSuccess || hipDeviceGetAttribute(&cus, hipDeviceAttributeMultiprocessorCount, dev) != hipSuccess) { grid = -1; return; }
        if (hipFuncSetAttribute((const void*)mega_fwd, hipFuncAttributeMaxDynamicSharedMemorySize, LDS_BYTES) != hipSuccess) { fprintf(stderr, "kernel_launch: hipFuncSetAttribute failed\n"); grid = -1; return; }
        if (hipOccupancyMaxActiveBlocksPerMultiprocessor(&per_cu, (const void*)mega_fwd, NWAVES * 64, LDS_BYTES) != hipSuccess || per_cu < 1) { fprintf(stderr, "kernel_launch: occupancy query failed (%d)\n", per_cu); per_cu = 1; }
        (void)hipGetLastError();
        grid = cus * per_cu;
    }
    if (grid < 0) return;
    Args a{};
    for (int i = 0; i < 17; ++i) a.in[i] = (const float*)d_in[i];
    a.out = (float*)d_out; a.ws = (unsigned char*)d_ws;
    if (N_LAUNCHES == 1) {
        a.ph_lo = 0; a.ph_hi = NPH;
        void* args[] = {&a};
        hipError_t e = hipLaunchCooperativeKernel((void*)mega_fwd, dim3(grid), dim3(NWAVES * 64), args, LDS_BYTES, stream);
        if (e != hipSuccess) fprintf(stderr, "kernel_launch: cooperative launch failed: %s (grid %d)\n", hipGetErrorString(e), grid);
    } else {
        for (int ph = 0; ph < NPH; ++ph) {
            a.ph_lo = ph; a.ph_hi = ph + 1;
            hipLaunchKernelGGL(mega_fwd, dim3(grid), dim3(NWAVES * 64), LDS_BYTES, stream, a);
        }
    }
}
```

```cpp
#include <hip/hip_runtime.h>
#include <hip/hip_cooperative_groups.h>
#include <cstdio>
#include <cstdint>
namespace cg = cooperative_groups;

#ifndef PHM
#define PHM 511
#endif
#ifndef MK_N_LAUNCHES
#define MK_N_LAUNCHES 1
#endif

constexpr int DM = 1024, DFF = 2816, NLAYER = 2;
constexpr int L_P = 2064, L_S = 16400, NSEQ_P = 16, NSEQ_S = 2;
constexpr int ROWS_P = NSEQ_P * L_P;
constexpr int M_REAL = ROWS_P + NSEQ_S * L_S;
constexpr int MP = 66048;
constexpr int NZ = 2304;
constexpr float EPS = 1e-6f;
static_assert(MP % 256 == 0 && MP >= M_REAL, "row padding");

namespace pg8 {
#define PG8_LAS __attribute__((address_space(3)))
typedef unsigned short bf16_t;
typedef short bf16x8 __attribute__((ext_vector_type(8)));
typedef float f32x4 __attribute__((ext_vector_type(4)));
typedef unsigned u32x4 __attribute__((ext_vector_type(4)));
constexpr int BM = 256, BK = 64, HALF = 128, HTB = HALF * BK * 2  , STAGE_BYTES = 8 * HTB, NXCD = 8, WGM = 8;

__host__ __device__ __forceinline__ int lds_byte(int r, int c) { const int st = (r >> 4) * 2 + (c >> 5), rr = r & 15, cc = c & 31, ob = rr * 64 + cc * 2; return st * 1024 + (ob ^ (((ob >> 9) & 1) << 5)); }
__host__ __device__ __forceinline__ void stage_rc(int b, int& R, int& C) { const int st = b / 1024, sb = b % 1024, swz = sb ^ (((sb >> 9) & 1) << 5); R = (st >> 1) * 16 + swz / 64; C = (st & 1) * 32 + (swz % 64) / 2; }
__host__ __device__ __forceinline__ int perm32(int rho) { const int n = rho >> 4, i = rho & 15; return 8 * (i >> 2) + 4 * n + (i & 3); }

struct Unit { int pm, pn; };
struct Gemm { const bf16_t* A; const bf16_t* A2; int pm_split; const bf16_t* Bt; int M, N, K, lda; };

struct StaticOrder {
    int nM, nN, nwg, G, c;
    __host__ __device__ void init(int M, int N, int G_, int c_) { nM = M / BM; nN = N / BM; nwg = nM * nN; G = G_; c = c_; }
    __host__ __device__ bool next(int i, Unit& u) const {
        const long L = (long)i * G + c; if (L >= nwg) return false;
        int wgid = (int)L; { const int q = nwg / NXCD, r = nwg % NXCD, xcd = wgid % NXCD, off = wgid / NXCD; wgid = (xcd < r ? xcd * (q + 1) : r * (q + 1) + (xcd - r) * q) + off; }
        const int nig = WGM * nN, gid = wgid / nig, fm = gid * WGM, gsz = (nM - fm) < WGM ? (nM - fm) : WGM;
        u.pm = fm + ((wgid % nig) % gsz); u.pn = (wgid % nig) / gsz; return true;
    }
    __device__ __forceinline__ void a_ready(const Unit&) const {}
    __device__ __forceinline__ void done(const Unit&) const {}
};


__device__ __forceinline__ unsigned cvt_pk_bf16(float lo, float hi) { unsigned r; asm volatile("v_cvt_pk_bf16_f32 %0, %1, %2" : "=v"(r) : "v"(lo), "v"(hi)); return r; }
__device__ __forceinline__ void st8(bf16_t* p, f32x4 a, f32x4 b) { u32x4 w; w.x = cvt_pk_bf16(a[0], a[1]); w.y = cvt_pk_bf16(a[2], a[3]); w.z = cvt_pk_bf16(b[0], b[1]); w.w = cvt_pk_bf16(b[2], b[3]); *(u32x4*)p = w; }
__device__ __forceinline__ float ssq4(f32x4 a) { return (a[0] * a[0] + a[1] * a[1]) + (a[2] * a[2] + a[3] * a[3]); }
__device__ __forceinline__ float red_fq(float p) { p += __shfl_xor(p, 16); p += __shfl_xor(p, 32); return p; }
__device__ __forceinline__ int row_pos(int r) {
    int pos;
    if (r < ROWS_P) pos = r % L_P; else { pos = (r - ROWS_P) % L_S; }
    return pos;
}

struct EpiZ {
    static constexpr bool PERM = true, AFTER_DRAIN = false;
    bf16_t* ZQ; bf16_t* GB; bf16_t* U; float* SSQ; const float* ssqX;
    __device__ __forceinline__ void operator()(const f32x4 (&acc)[2][2][4][2], const Unit& u, int wr, int wc, int fr, int fq) const {
        asm volatile("" : "+v"(fr), "+v"(fq)); asm volatile("" : "+s"(wr), "+s"(wc));
        const int row0 = u.pm * BM + wr * 64 + fr, pn = u.pn, cw = wc * 32 + fq * 8;
#pragma unroll
        for (int ai = 0; ai < 2; ++ai)
#pragma unroll
            for (int m = 0; m < 4; ++m) {
                const int row = row0 + ai * HALF + m * 16;
                const float s = rsqrtf(ssqX[row] * (1.0f / 1024.0f) + EPS);
                const f32x4 a0 = acc[ai][0][m][0] * s, a1 = acc[ai][0][m][1] * s, b0 = acc[ai][1][m][0] * s, b1 = acc[ai][1][m][1] * s;
                if (pn < 3) {
                    bf16_t* p = ZQ + (size_t)row * 768 + pn * 256 + cw;
                    st8(p, a0, a1); st8(p + HALF, b0, b1);
                    const float pa = red_fq(ssq4(a0) + ssq4(a1)), pb = red_fq(ssq4(b0) + ssq4(b1));
                    if (fq == 0) { SSQ[(size_t)row * 32 + pn * 8 + wc] = pa; SSQ[(size_t)row * 32 + pn * 8 + 4 + wc] = pb; }
                } else if (pn < 5) {
                    bf16_t* p = GB + (size_t)row * 512 + (pn - 3) * 256 + cw;
                    st8(p, a0, a1); st8(p + HALF, b0, b1);
                } else {
                    bf16_t* p = U + (size_t)row * 512 + (pn - 5) * 128 + cw;
                    st8(p, a0 * b0, a1 * b1);
                }
                asm volatile("" ::: "memory");
            }
    }
};
struct EpiQ {
    static constexpr bool PERM = true, AFTER_DRAIN = false;
    bf16_t* Q; const float* SSQ; const float* ROPE;
    __device__ __forceinline__ void operator()(const f32x4 (&acc)[2][2][4][2], const Unit& u, int wr, int wc, int fr, int fq) const {
        asm volatile("" : "+v"(fr), "+v"(fq)); asm volatile("" : "+s"(wr), "+s"(wc));
        const int row0 = u.pm * BM + wr * 64 + fr, pn = u.pn, cw = wc * 32 + fq * 8;
#pragma unroll
        for (int ai = 0; ai < 2; ++ai)
#pragma unroll
            for (int m = 0; m < 4; ++m) {
                const int row = row0 + ai * HALF + m * 16;
                const f32x4* sp = (const f32x4*)(SSQ + (size_t)row * 32);
                const f32x4 s0 = sp[0], s1 = sp[1], s2 = sp[2];
                const float ss = ((s0[0] + s0[1]) + (s0[2] + s0[3])) + ((s1[0] + s1[1]) + (s1[2] + s1[3])) + ((s2[0] + s2[1]) + (s2[2] + s2[3]));
                const float s = rsqrtf(ss * (1.0f / 384.0f) + EPS) * 0.10411754116f;
                const f32x4 a0 = acc[ai][0][m][0] * s, a1 = acc[ai][0][m][1] * s, b0 = acc[ai][1][m][0] * s, b1 = acc[ai][1][m][1] * s;
                bf16_t* qrow = Q + (size_t)row * 768;
                if (pn < 2) { st8(qrow + pn * 256 + cw, a0, a1); st8(qrow + pn * 256 + HALF + cw, b0, b1); }
                else {
                    const int pos = row_pos(row);
                    const f32x4* cp = (const f32x4*)(ROPE + (size_t)pos * 64 + fq * 8);
                    const f32x4 c0 = cp[0], c1 = cp[1], n0 = cp[8], n1 = cp[9];
                    st8(qrow + 512 + cw, a0 * c0 - b0 * n0, a1 * c1 - b1 * n1);
                    st8(qrow + 640 + cw, b0 * c0 + a0 * n0, b1 * c1 + a1 * n1);
                }
                asm volatile("" ::: "memory");
            }
    }
};
struct EpiKV {
    static constexpr bool PERM = true, AFTER_DRAIN = false;
    bf16_t* KN; bf16_t* V; const float* SSQ;
    __device__ __forceinline__ void operator()(const f32x4 (&acc)[2][2][4][2], const Unit& u, int wr, int wc, int fr, int fq) const {
        asm volatile("" : "+v"(fr), "+v"(fq)); asm volatile("" : "+s"(wr), "+s"(wc));
        const int row0 = u.pm * BM + wr * 64 + fr, pn = u.pn, cw = wc * 32 + fq * 8;
        bf16_t* base = (pn < 2) ? KN + pn * 256 : V + (pn - 2) * 256;
#pragma unroll
        for (int ai = 0; ai < 2; ++ai)
#pragma unroll
            for (int m = 0; m < 4; ++m) {
                const int row = row0 + ai * HALF + m * 16;
                const f32x4* sp = (const f32x4*)(SSQ + (size_t)row * 32);
                const f32x4 s0 = sp[3], s1 = sp[4];
                const float ss = ((s0[0] + s0[1]) + (s0[2] + s0[3])) + ((s1[0] + s1[1]) + (s1[2] + s1[3]));
                const float s = rsqrtf(ss * (1.0f / 256.0f) + EPS);
                bf16_t* p = base + (size_t)row * 512 + cw;
                st8(p, acc[ai][0][m][0] * s, acc[ai][0][m][1] * s); st8(p + HALF, acc[ai][1][m][0] * s, acc[ai][1][m][1] * s);
                asm volatile("" ::: "memory");
            }
    }
};
struct EpiMix {
    static constexpr bool PERM = true, AFTER_DRAIN = false;
    bf16_t* OUT; float* SSQ;
    __device__ __forceinline__ void operator()(const f32x4 (&acc)[2][2][4][2], const Unit& u, int wr, int wc, int fr, int fq) const {
        asm volatile("" : "+v"(fr), "+v"(fq)); asm volatile("" : "+s"(wr), "+s"(wc));
        const int row0 = u.pm * BM + wr * 64 + fr, pn = u.pn, cw = wc * 32 + fq * 8;
#pragma unroll
        for (int ai = 0; ai < 2; ++ai)
#pragma unroll
            for (int m = 0; m < 4; ++m) {
                const int row = row0 + ai * HALF + m * 16;
                const f32x4 a0 = acc[ai][0][m][0], a1 = acc[ai][0][m][1], b0 = acc[ai][1][m][0], b1 = acc[ai][1][m][1];
                bf16_t* p = OUT + (size_t)row * 1024 + pn * 256 + cw;
                st8(p, a0, a1); st8(p + HALF, b0, b1);
                const float pa = red_fq(ssq4(a0) + ssq4(a1)), pb = red_fq(ssq4(b0) + ssq4(b1));
                if (fq == 0) { SSQ[(size_t)row * 32 + pn * 8 + wc] = pa; SSQ[(size_t)row * 32 + pn * 8 + 4 + wc] = pb; }
            }
    }
};
struct EpiAct {
    static constexpr bool PERM = true, AFTER_DRAIN = false;
    bf16_t* ACT1; bf16_t* ACT2; int pm_split; const float* ssqX;
    __device__ __forceinline__ void operator()(const f32x4 (&acc)[2][2][4][2], const Unit& u, int wr, int wc, int fr, int fq) const {
        asm volatile("" : "+v"(fr), "+v"(fq)); asm volatile("" : "+s"(wr), "+s"(wc));
        const int rl0 = wr * 64 + fr, pn = u.pn, cw = wc * 32 + fq * 8;
        bf16_t* base = (u.pm < pm_split) ? ACT1 + (size_t)u.pm * BM * 2816 : ACT2 + (size_t)(u.pm - pm_split) * BM * 2816;
#pragma unroll
        for (int ai = 0; ai < 2; ++ai)
#pragma unroll
            for (int m = 0; m < 4; ++m) {
                const int rl = rl0 + ai * HALF + m * 16;
                const float s = rsqrtf(ssqX[u.pm * BM + rl] * (1.0f / 1024.0f) + EPS);
                f32x4 o[2];
#pragma unroll
                for (int n = 0; n < 2; ++n) {
                    const f32x4 g = acc[ai][0][m][n] * s, up = acc[ai][1][m][n] * s;
#pragma unroll
                    for (int j = 0; j < 4; ++j) { const float e = __builtin_amdgcn_exp2f(g[j] * -1.4426950408889634f); o[n][j] = g[j] * __builtin_amdgcn_rcpf(1.0f + e) * up[j]; }
                }
                st8(base + (size_t)rl * 2816 + pn * 128 + cw, o[0], o[1]);
                asm volatile("" ::: "memory");
            }
    }
};

template <class Epi, class Sched, bool ALIGN_EPI = false, bool SP2 = false>
__device__ __forceinline__ void gemm_phase(PG8_LAS unsigned char* lds, const Gemm g, const Sched& S, const Epi& E) {
    int tid = threadIdx.x; asm volatile("" : "+v"(tid));
    const int wid = __builtin_amdgcn_readfirstlane(tid >> 6), lane = tid & 63, wr = wid >> 2, wc = wid & 3, fr = lane & 15, fq = lane >> 4;
    int K = g.K; asm volatile("" : "+s"(K));
    const int nt = K / BK;
    unsigned voffA[2], voffB[2];
#pragma unroll
    for (int i = 0; i < 2; ++i) { int R, C; stage_rc(tid * 16 + i * 8192, R, C); const int Rb = Epi::PERM ? ((R & ~31) + perm32(R & 31)) : R;
        voffA[i] = (unsigned)(R * g.lda + C) * 2u; voffB[i] = (unsigned)(Rb * K + C) * 2u; }
    const size_t kstep = (size_t)(BK * 2);
    const size_t hstepA = (size_t)HALF * g.lda * 2, hstepB = (size_t)HALF * K * 2;
    const size_t tstepA = 2 * hstepA, tstepB = 2 * hstepB;
    const unsigned ldsw = (unsigned)wid * 1024u;
    const int aoff = lds_byte(wr * 64 + fr, fq * 8), boff = lds_byte(wc * 32 + fr, fq * 8);
#define PG8_SA(b, h) (((b) * 2 + (h)) * HTB)
#define PG8_SB(b, h) ((4 + (b) * 2 + (h)) * HTB)
#define PG8_STAGE(bufoff, gbase, voff) do { _Pragma("unroll") for (int _i = 0; _i < 2; ++_i) \
        __builtin_amdgcn_global_load_lds((const unsigned*)((const char*)(gbase) + (voff)[_i]), (PG8_LAS unsigned*)(lds + (bufoff) + ldsw + _i * 8192), 16, 0, 0); } while (0)
#define PG8_LDA(dst, b, h) do { _Pragma("unroll") for (int m = 0; m < 4; ++m) _Pragma("unroll") for (int k = 0; k < 2; ++k) dst[m][k] = *(const PG8_LAS bf16x8*)(lds + PG8_SA(b, h) + aoff + m * 2048 + k * 1024); } while (0)
#define PG8_LDB(dst, b, h) do { _Pragma("unroll") for (int n = 0; n < 2; ++n) _Pragma("unroll") for (int k = 0; k < 2; ++k) dst[n][k] = *(const PG8_LAS bf16x8*)(lds + PG8_SB(b, h) + boff + n * 2048 + k * 1024); } while (0)
#define PG8_MMA(ai, bj, At, Bt) do { __builtin_amdgcn_s_setprio(1); _Pragma("unroll") for (int m = 0; m < 4; ++m) _Pragma("unroll") for (int n = 0; n < 2; ++n) _Pragma("unroll") for (int k = 0; k < 2; ++k) \
        acc[ai][bj][m][n] = __builtin_amdgcn_mfma_f32_16x16x32_bf16(Bt[n][k], At[m][k], acc[ai][bj][m][n], 0, 0, 0); __builtin_amdgcn_s_setprio(0); } while (0)
#define PG8_WAIT_V(n) asm volatile("s_waitcnt vmcnt(" #n ")" ::: "memory")
#define PG8_WAIT_L(n) asm volatile("s_waitcnt lgkmcnt(" #n ")" ::: "memory")
#define PG8_BAR __builtin_amdgcn_s_barrier()
#define PG8_SCHED __builtin_amdgcn_sched_barrier(0)
    Unit cur, nxt; int ui = 0;
    if (!S.next(0, cur)) return;
    f32x4 acc[2][2][4][2];
#pragma unroll
    for (int a = 0; a < 2; ++a)
#pragma unroll
        for (int b = 0; b < 2; ++b)
#pragma unroll
            for (int m = 0; m < 4; ++m)
#pragma unroll
                for (int n = 0; n < 2; ++n) acc[a][b][m][n] = (f32x4){0.f, 0.f, 0.f, 0.f};
    bf16x8 At[4][2], B0[2][2], B1[2][2];
    const char* cA = (cur.pm < g.pm_split) ? (const char*)g.A + (size_t)cur.pm * tstepA : (const char*)g.A2 + (size_t)(cur.pm - g.pm_split) * tstepA; const char* cB = (const char*)g.Bt + (size_t)cur.pn * tstepB;
    S.a_ready(cur);
    if constexpr (SP2) {
        PG8_STAGE(PG8_SB(0, 0), cB, voffB); PG8_STAGE(PG8_SB(0, 1), cB + hstepB, voffB); PG8_STAGE(PG8_SA(0, 0), cA, voffA); PG8_STAGE(PG8_SA(0, 1), cA + hstepA, voffA);
        if (wr == 1) PG8_BAR;
        PG8_WAIT_V(2); PG8_BAR;
        PG8_STAGE(PG8_SB(1, 0), cB + kstep, voffB); PG8_STAGE(PG8_SA(1, 0), cA + kstep, voffA); PG8_STAGE(PG8_SB(1, 1), cB + hstepB + kstep, voffB);
        PG8_WAIT_V(6); PG8_BAR;
    } else {
        PG8_STAGE(PG8_SB(0, 0), cB, voffB); PG8_STAGE(PG8_SA(0, 0), cA, voffA); PG8_STAGE(PG8_SB(0, 1), cB + hstepB, voffB); PG8_STAGE(PG8_SA(0, 1), cA + hstepA, voffA);
        if (wr == 1) PG8_BAR;
        PG8_WAIT_V(4); PG8_BAR;
        PG8_STAGE(PG8_SB(1, 0), cB + kstep, voffB); PG8_STAGE(PG8_SA(1, 0), cA + kstep, voffA); PG8_STAGE(PG8_SB(1, 1), cB + hstepB + kstep, voffB);
        PG8_WAIT_V(6); PG8_BAR;
    }
    for (;;) {
        const bool has_next = S.next(ui + 1, nxt);
        const char* nA = has_next ? ((nxt.pm < g.pm_split) ? (const char*)g.A + (size_t)nxt.pm * tstepA : (const char*)g.A2 + (size_t)(nxt.pm - g.pm_split) * tstepA) : cA; const char* nB = has_next ? (const char*)g.Bt + (size_t)nxt.pn * tstepB : cB;
        for (int t = 0; t < nt; t += 2) {
            const bool last = (t == nt - 2);
            const char* a1 = cA + (size_t)(t + 1) * kstep;
            const char* a2 = last ? nA : cA + (size_t)(t + 2) * kstep; const char* b2 = last ? nB : cB + (size_t)(t + 2) * kstep;
            const char* a3 = a2 + kstep; const char* b3 = b2 + kstep;
            if (last && has_next) S.a_ready(nxt);
            if constexpr (SP2) {
            PG8_LDB(B0, 0, 0); PG8_LDB(B1, 0, 1); PG8_SCHED; PG8_LDA(At, 0, 0); PG8_STAGE(PG8_SA(1, 1), a1 + hstepA, voffA);
            PG8_WAIT_V(8); PG8_WAIT_L(0); PG8_BAR; PG8_MMA(0, 0, At, B0); PG8_MMA(0, 1, At, B1); PG8_BAR; PG8_SCHED;
            PG8_LDA(At, 0, 1); PG8_STAGE(PG8_SB(0, 0), b2, voffB); PG8_STAGE(PG8_SB(0, 1), b2 + hstepB, voffB); PG8_STAGE(PG8_SA(0, 0), a2, voffA);
            PG8_WAIT_V(8); PG8_WAIT_L(0); PG8_BAR; PG8_MMA(1, 0, At, B0); PG8_MMA(1, 1, At, B1); PG8_BAR; PG8_SCHED;
            PG8_LDB(B0, 1, 0); PG8_LDB(B1, 1, 1); PG8_SCHED; PG8_LDA(At, 1, 0); PG8_STAGE(PG8_SA(0, 1), a2 + hstepA, voffA);
            PG8_WAIT_V(8); PG8_WAIT_L(0); PG8_BAR; PG8_MMA(0, 0, At, B0); PG8_MMA(0, 1, At, B1); PG8_BAR; PG8_SCHED;
            PG8_LDA(At, 1, 1); PG8_STAGE(PG8_SB(1, 0), b3, voffB); PG8_STAGE(PG8_SB(1, 1), b3 + hstepB, voffB); PG8_STAGE(PG8_SA(1, 0), a3, voffA);
            PG8_WAIT_V(8); PG8_WAIT_L(0); PG8_BAR; PG8_MMA(1, 0, At, B0); PG8_MMA(1, 1, At, B1); PG8_BAR; PG8_SCHED;
            } else {
            PG8_LDB(B0, 0, 0); PG8_SCHED; PG8_LDA(At, 0, 0); PG8_STAGE(PG8_SA(1, 1), a1 + hstepA, voffA);
            PG8_WAIT_L(8); PG8_BAR; PG8_WAIT_L(0); PG8_MMA(0, 0, At, B0); PG8_BAR; PG8_SCHED;
            PG8_LDB(B1, 0, 1); PG8_STAGE(PG8_SB(0, 0), b2, voffB);
            PG8_BAR; PG8_WAIT_L(0); PG8_MMA(0, 1, At, B1); PG8_BAR;
            PG8_LDA(At, 0, 1); PG8_STAGE(PG8_SA(0, 0), a2, voffA);
            PG8_BAR; PG8_WAIT_L(0); PG8_MMA(1, 0, At, B0); PG8_BAR; PG8_SCHED;
            PG8_STAGE(PG8_SB(0, 1), b2 + hstepB, voffB);
            PG8_WAIT_V(6); PG8_BAR; PG8_MMA(1, 1, At, B1); PG8_BAR;
            PG8_LDB(B0, 1, 0); PG8_SCHED; PG8_LDA(At, 1, 0); PG8_STAGE(PG8_SA(0, 1), a2 + hstepA, voffA);
            PG8_WAIT_L(8); PG8_BAR; PG8_WAIT_L(0); PG8_MMA(0, 0, At, B0); PG8_BAR; PG8_SCHED;
            PG8_LDB(B1, 1, 1); PG8_STAGE(PG8_SB(1, 0), b3, voffB);
            PG8_BAR; PG8_WAIT_L(0); PG8_MMA(0, 1, At, B1); PG8_BAR;
            PG8_LDA(At, 1, 1); PG8_STAGE(PG8_SA(1, 0), a3, voffA);
            PG8_BAR; PG8_WAIT_L(0); PG8_MMA(1, 0, At, B0); PG8_BAR; PG8_SCHED;
            PG8_STAGE(PG8_SB(1, 1), b3 + hstepB, voffB);
            PG8_WAIT_V(6); PG8_BAR; PG8_MMA(1, 1, At, B1); PG8_BAR;
            }
        }
        if constexpr (ALIGN_EPI) { if (wr == 0) PG8_BAR; }
        if constexpr (!Epi::AFTER_DRAIN) { E(acc, cur, wr, wc, fr, fq); S.done(cur); }
        if (!has_next) break;
#pragma unroll
        for (int a = 0; a < 2; ++a)
#pragma unroll
            for (int b = 0; b < 2; ++b)
#pragma unroll
                for (int m = 0; m < 4; ++m)
#pragma unroll
                    for (int n = 0; n < 2; ++n) acc[a][b][m][n] = (f32x4){0.f, 0.f, 0.f, 0.f};
        cur = nxt; cA = nA; cB = nB; ++ui;
        if constexpr (ALIGN_EPI) { if (wr == 1) PG8_BAR; }
    }
    PG8_WAIT_V(0);
    if constexpr (!ALIGN_EPI) { if (wr == 0) PG8_BAR; }
    PG8_BAR;
    if constexpr (Epi::AFTER_DRAIN) { E.fused(acc, cur, wr, wc, fr, fq, lds, wid, lane); S.done(cur); }
#undef PG8_SA
#undef PG8_SB
#undef PG8_STAGE
#undef PG8_LDA
#undef PG8_LDB
#undef PG8_MMA
#undef PG8_WAIT_V
#undef PG8_WAIT_L
#undef PG8_BAR
#undef PG8_SCHED
}
}

namespace att {
typedef unsigned short bf16;
typedef __attribute__((ext_vector_type(8))) short bf16x8;
typedef __attribute__((ext_vector_type(4))) short s16x4;
typedef __attribute__((ext_vector_type(16))) float f32x16;
typedef __attribute__((ext_vector_type(4))) unsigned u32x4;
constexpr int KVBLK = 64;
constexpr float SCALE = 0.07216878364870323f;
constexpr float THR = 8.f;
constexpr int SHM_V = 16384, SHM_KN = 16384, SHM_KR = 8192;
constexpr int OFF_V = 0, OFF_KN = 32768, OFF_KR = 65536, OFF_WS = 81920, OFF_QR = 83968, OFF_FLAG = 83968 + 8 * 4096, ATT_LDS = OFF_FLAG + 16;
constexpr int NPIECE = 7;
#define SBAR() __builtin_amdgcn_sched_barrier(0)
__device__ __forceinline__ int crow(int r, int hi) { return (r & 3) + 8 * (r >> 2) + 4 * hi; }
__device__ __forceinline__ unsigned cvtpk(float lo, float hi) { unsigned r; asm volatile("v_cvt_pk_bf16_f32 %0, %1, %2" : "=v"(r) : "v"(lo), "v"(hi)); return r; }
__device__ __forceinline__ bf16x8 ld8(const bf16* p) { return *reinterpret_cast<const bf16x8*>(p); }

constexpr float THRL = THR * 1.4426950408889634f;
template <bool START>
__device__ __forceinline__ void partialSM(f32x16& p0, f32x16& p1, float& mhat, f32x16& negm, float& alpha) {
  float pmax = p0[0];
#pragma unroll
  for (int r = 1; r < 16; ++r) pmax = fmaxf(pmax, p0[r]);
#pragma unroll
  for (int r = 0; r < 16; ++r) pmax = fmaxf(pmax, p1[r]);
  { auto rr = __builtin_amdgcn_permlane32_swap(__float_as_uint(pmax), __float_as_uint(pmax), false, false);
    pmax = fmaxf(__uint_as_float(rr[0]), __uint_as_float(rr[1])); }
  alpha = 1.f;
  if (START || __builtin_expect(__any(pmax > THRL), 0)) {
    const float dl = START ? pmax : fmaxf(pmax, 0.f);
    mhat += dl;
#pragma unroll
    for (int r = 0; r < 16; ++r) { p0[r] -= dl; p1[r] -= dl; }
#pragma unroll
    for (int r = 0; r < 16; ++r) negm[r] = -mhat;
    asm volatile("" : "+v"(negm));
    if (!START) alpha = __builtin_amdgcn_exp2f(-dl);
  }
#pragma unroll
  for (int r = 0; r < 16; ++r) p0[r] = __builtin_amdgcn_exp2f(p0[r]);
}
__device__ __forceinline__ void finishSM(f32x16& p0, f32x16& p1, float alpha, float& l_reg, bf16x8& pa0, bf16x8& pa1, bf16x8& pa2, bf16x8& pa3) {
#pragma unroll
  for (int r = 0; r < 16; ++r) p1[r] = __builtin_amdgcn_exp2f(p1[r]);
  float ps = 0;
#pragma unroll
  for (int r = 0; r < 16; ++r) ps += p0[r];
#pragma unroll
  for (int r = 0; r < 16; ++r) ps += p1[r];
  { auto rr = __builtin_amdgcn_permlane32_swap(__float_as_uint(ps), __float_as_uint(ps), false, false);
    ps = __uint_as_float(rr[0]) + __uint_as_float(rr[1]); }
  l_reg = l_reg * alpha + ps;
#define PK4(P, BASE, OUT) do { unsigned a0 = cvtpk(P[BASE + 0], P[BASE + 1]), a1 = cvtpk(P[BASE + 2], P[BASE + 3]);   \
    unsigned b0 = cvtpk(P[BASE + 4], P[BASE + 5]), b1 = cvtpk(P[BASE + 6], P[BASE + 7]);                              \
    auto r0 = __builtin_amdgcn_permlane32_swap(a0, b0, false, false); auto r1 = __builtin_amdgcn_permlane32_swap(a1, b1, false, false); \
    u32x4 w = {r0[0], r1[0], r0[1], r1[1]}; OUT = *reinterpret_cast<bf16x8*>(&w); } while (0)
  PK4(p0, 0, pa0); PK4(p0, 8, pa1); PK4(p1, 0, pa2); PK4(p1, 8, pa3);
#undef PK4
}
__device__ __forceinline__ void kmask(f32x16& p0, f32x16& p1, int nv, int hi) {
#pragma unroll
  for (int r = 0; r < 16; ++r) { const int k = crow(r, hi); if (k >= nv) p0[r] = -1e30f; if (k + 32 >= nv) p1[r] = -1e30f; }
}
template <int OFF> __device__ __forceinline__ bf16x8 dsr128(int addr) { bf16x8 r; asm volatile("ds_read_b128 %0, %1 offset:%2" : "=&v"(r) : "v"(addr), "i"(OFF) : "memory"); return r; }
#define LGKM_W2(n, x, y) asm volatile("s_waitcnt lgkmcnt(" #n ")" : "+v"(x), "+v"(y) :: "memory")
#define LGKM_W3(n, x, y, z) asm volatile("s_waitcnt lgkmcnt(" #n ")" : "+v"(x), "+v"(y), "+v"(z) :: "memory")
__device__ __forceinline__ void qkt(f32x16& p0, f32x16& p1, const char* Kn, const char* Kr, const char* Qr, const bf16x8* qr, const f32x16& negm, int lane) {
  const int kn = (int)(uintptr_t)Kn + (lane & 31) * 16 + (lane >> 5) * 1024, kr = (int)(uintptr_t)Kr + (lane & 31) * 16 + (lane >> 5) * 1024, qa = (int)(uintptr_t)Qr + lane * 16;
  bf16x8 a0, a1, b0, b1, qa_, qb_;
#define MM(K0, K1, QQ) do { p0 = __builtin_amdgcn_mfma_f32_32x32x16_bf16(K0, QQ, p0, 0, 0, 0); p1 = __builtin_amdgcn_mfma_f32_32x32x16_bf16(K1, QQ, p1, 0, 0, 0); } while (0)
  a0 = dsr128<0 * 2048>(kn); a1 = dsr128<0 * 2048 + 512>(kn);
  b0 = dsr128<1 * 2048>(kn); b1 = dsr128<1 * 2048 + 512>(kn); LGKM_W2(2, a0, a1);
  p0 = __builtin_amdgcn_mfma_f32_32x32x16_bf16(a0, qr[0], negm, 0, 0, 0); p1 = __builtin_amdgcn_mfma_f32_32x32x16_bf16(a1, qr[0], negm, 0, 0, 0);
  a0 = dsr128<2 * 2048>(kn); a1 = dsr128<2 * 2048 + 512>(kn); LGKM_W2(2, b0, b1); MM(b0, b1, qr[1]);
  b0 = dsr128<3 * 2048>(kn); b1 = dsr128<3 * 2048 + 512>(kn); LGKM_W2(2, a0, a1); MM(a0, a1, qr[2]);
  a0 = dsr128<4 * 2048>(kn); a1 = dsr128<4 * 2048 + 512>(kn); LGKM_W2(2, b0, b1); MM(b0, b1, qr[3]);
  b0 = dsr128<5 * 2048>(kn); b1 = dsr128<5 * 2048 + 512>(kn); LGKM_W2(2, a0, a1); MM(a0, a1, qr[4]);
  a0 = dsr128<6 * 2048>(kn); a1 = dsr128<6 * 2048 + 512>(kn); LGKM_W2(2, b0, b1); MM(b0, b1, qr[5]);
  b0 = dsr128<7 * 2048>(kn); b1 = dsr128<7 * 2048 + 512>(kn); LGKM_W2(2, a0, a1); MM(a0, a1, qr[6]);
  a0 = dsr128<0 * 2048>(kr); a1 = dsr128<0 * 2048 + 512>(kr); qa_ = dsr128<0 * 1024>(qa); LGKM_W2(3, b0, b1); MM(b0, b1, qr[7]);
  b0 = dsr128<1 * 2048>(kr); b1 = dsr128<1 * 2048 + 512>(kr); qb_ = dsr128<1 * 1024>(qa); LGKM_W3(3, a0, a1, qa_); MM(a0, a1, qa_);
  a0 = dsr128<2 * 2048>(kr); a1 = dsr128<2 * 2048 + 512>(kr); qa_ = dsr128<2 * 1024>(qa); LGKM_W3(3, b0, b1, qb_); MM(b0, b1, qb_);
  b0 = dsr128<3 * 2048>(kr); b1 = dsr128<3 * 2048 + 512>(kr); qb_ = dsr128<3 * 1024>(qa); LGKM_W3(3, a0, a1, qa_); MM(a0, a1, qa_);
  LGKM_W3(0, b0, b1, qb_); MM(b0, b1, qb_);
#undef MM
}
__device__ __forceinline__ int v_st(int k, int c) { const int kk = (k & ~0xC) | ((k & 4) << 1) | ((k & 8) >> 1); return ((kk >> 3) * 4 + (c >> 5)) * 512 + ((kk & 7) * 32 + (c & 31)) * 2; }
__device__ __forceinline__ int v_rd_base(int lane) { return ((lane & 3) << 3) | (((lane >> 2) & 3) << 6) | (((lane >> 4) & 1) << 5) | (((lane >> 5) & 1) << 8); }
constexpr int v_rd_off(int d0, int ks, int half) { return d0 * 512 + ks * 4096 + half * 2048; }
template <int OFF> __device__ __forceinline__ s16x4 tr_read(int vb) {
  s16x4 r; asm volatile("ds_read_b64_tr_b16 %0, %1 offset:%2" : "=&v"(r) : "v"(vb), "i"(OFF) : "memory"); return r;
}
struct VF { s16x4 l0, h0, l1, h1, l2, h2, l3, h3; };
template <int D0> __device__ __forceinline__ void pv_rd(VF& f, int vb) {
  f.l0 = tr_read<v_rd_off(D0, 0, 0)>(vb); f.h0 = tr_read<v_rd_off(D0, 0, 1)>(vb); f.l1 = tr_read<v_rd_off(D0, 1, 0)>(vb); f.h1 = tr_read<v_rd_off(D0, 1, 1)>(vb);
  f.l2 = tr_read<v_rd_off(D0, 2, 0)>(vb); f.h2 = tr_read<v_rd_off(D0, 2, 1)>(vb); f.l3 = tr_read<v_rd_off(D0, 3, 0)>(vb); f.h3 = tr_read<v_rd_off(D0, 3, 1)>(vb);
}
#define PV_WAIT(n, f) asm volatile("s_waitcnt lgkmcnt(" #n ")" : "+v"(f.l0), "+v"(f.h0), "+v"(f.l1), "+v"(f.h1), "+v"(f.l2), "+v"(f.h2), "+v"(f.l3), "+v"(f.h3) :: "memory")
__device__ __forceinline__ void pv_mm(f32x16& od, const VF& f, bf16x8 pa0, bf16x8 pa1, bf16x8 pa2, bf16x8 pa3) {
#define PK(L, H) (bf16x8){L[0], L[1], L[2], L[3], H[0], H[1], H[2], H[3]}
  od = __builtin_amdgcn_mfma_f32_32x32x16_bf16(pa0, PK(f.l0, f.h0), od, 0, 0, 0);
  od = __builtin_amdgcn_mfma_f32_32x32x16_bf16(pa1, PK(f.l1, f.h1), od, 0, 0, 0);
  od = __builtin_amdgcn_mfma_f32_32x32x16_bf16(pa2, PK(f.l2, f.h2), od, 0, 0, 0);
  od = __builtin_amdgcn_mfma_f32_32x32x16_bf16(pa3, PK(f.l3, f.h3), od, 0, 0, 0);
#undef PK
}
__device__ __forceinline__ void pv_d0(f32x16* o, int vb, bf16x8 pa0, bf16x8 pa1, bf16x8 pa2, bf16x8 pa3) {
  VF fa, fb;
  pv_rd<0>(fa, vb);
  pv_rd<1>(fb, vb); PV_WAIT(8, fa); pv_mm(o[0], fa, pa0, pa1, pa2, pa3);
  pv_rd<2>(fa, vb); PV_WAIT(8, fb); pv_mm(o[1], fb, pa0, pa1, pa2, pa3);
  pv_rd<3>(fb, vb); PV_WAIT(8, fa); pv_mm(o[2], fa, pa0, pa1, pa2, pa3);
  PV_WAIT(0, fb); pv_mm(o[3], fb, pa0, pa1, pa2, pa3);
}
__device__ __forceinline__ unsigned short f2bf16(float f) { unsigned u = __builtin_bit_cast(unsigned, f); return (unsigned short)((u + 0x7fffu + ((u >> 16) & 1u)) >> 16); }

__device__ __forceinline__ void attn_unit(const bf16* __restrict__ Qg, const bf16* __restrict__ KNg, const bf16* __restrict__ KRg, const bf16* __restrict__ Vg, bf16* __restrict__ AO,
                                          long row0, int L, int h, int q0, char* lds, int tbeg, int NT, float* part, unsigned* cnt, int piece) {
  int tid = threadIdx.x; asm volatile("" : "+v"(tid));
  const int wid = __builtin_amdgcn_readfirstlane(tid >> 6), lane = tid & 63, r32 = lane & 31, hi = lane >> 5;
  char* V_lds = lds + OFF_V; char* KN_lds = lds + OFF_KN; char* KR_lds = lds + OFF_KR;
  float* ws = (float*)(lds + OFF_WS) + wid * 64; float* li_l = ws; float* al_l = ws + 32;
  float mhat = 0.f, l_reg = 0; f32x16 negm = f32x16{}; asm volatile("" : "+v"(negm)); f32x16 o[4] = {}; bf16x8 qr[8]; char* QR_lds = lds + OFF_QR + wid * 4096;
  const bf16* Qw = Qg + (row0 + q0 + wid * 32 + r32) * 768;
#pragma unroll
  for (int d0 = 0; d0 < 8; ++d0) qr[d0] = ld8(Qw + 128 * h + d0 * 16 + hi * 8);
  { const bf16x8 t0 = ld8(Qw + 512 + 32 * h + hi * 8), t1 = ld8(Qw + 512 + 32 * h + 16 + hi * 8), t2 = ld8(Qw + 640 + 32 * h + hi * 8), t3 = ld8(Qw + 640 + 32 * h + 16 + hi * 8);
    *(bf16x8*)(QR_lds + lane * 16) = t0; *(bf16x8*)(QR_lds + lane * 16 + 1024) = t1;
    *(bf16x8*)(QR_lds + lane * 16 + 2048) = t2; *(bf16x8*)(QR_lds + lane * 16 + 3072) = t3; }
  const int sr = tid >> 4, sc = (tid & 15) * 8, vst0 = v_st(sr, sc), vst1 = v_st(32 + sr, sc);
  const int krow = 8 * wid + (lane & 7), kc8 = lane >> 3;
  const int kwoff = (kc8 >> 1) * 2048 + (kc8 & 1) * 1024 + (krow >> 5) * 512 + (krow & 31) * 16;
  const int vb0 = (int)(uintptr_t)V_lds + v_rd_base(lane);
  const bf16* Vh = Vg + row0 * 512 + 128 * h;
  const bf16* Kh = KNg + row0 * 512 + 128 * h;
  const bf16* Rh = KRg + row0 * 64;
  const unsigned kvoff = (unsigned)(sr * 512 + sc), knoff = (unsigned)(krow * 512 + kc8 * 8), kroff = (unsigned)(krow * 64 + kc8 * 8);
  bf16x8 vs0, vs1, ks0, ks1, kr0;
#define KLOAD(k0) do { const bf16* kt_ = Kh + (long)(k0) * 512; const bf16* rt_ = Rh + (long)(k0) * 64; ks0 = ld8(kt_ + knoff); ks1 = ld8(kt_ + 64 + knoff); kr0 = ld8(rt_ + kroff); } while (0)
#define VLOAD(k0) do { const bf16* vt_ = Vh + (long)(k0) * 512; vs0 = ld8(vt_ + kvoff); vs1 = ld8(vt_ + 32 * 512 + kvoff); } while (0)
#define KWRITE(b) do { *(bf16x8*)(KN_lds + (b) * SHM_KN + kwoff) = ks0; *(bf16x8*)(KN_lds + (b) * SHM_KN + 8192 + kwoff) = ks1; *(bf16x8*)(KR_lds + (b) * SHM_KR + kwoff) = kr0; } while (0)
#define VWRITE(b) do { *(bf16x8*)(V_lds + (b) * SHM_V + vst0) = vs0; *(bf16x8*)(V_lds + (b) * SHM_V + vst1) = vs1; } while (0)
#define SWAIT() asm volatile("s_waitcnt vmcnt(0)" ::: "memory")
#define RESC(a) do { if (__any((a) < 1.f)) { if (hi == 0) al_l[r32] = (a); asm volatile("s_waitcnt lgkmcnt(0)" ::: "memory"); \
    _Pragma("unroll") for (int d = 0; d < 4; ++d) _Pragma("unroll") for (int r = 0; r < 16; ++r) o[d][r] *= al_l[crow(r, hi)]; } } while (0)
  f32x16 pA0, pA1, pB0, pB1; float alA, alB; bf16x8 pa0, pa1, pa2, pa3;
  const int NTt = (L + KVBLK - 1) / KVBLK, nv_last = L - (NTt - 1) * KVBLK;
  if (wid >= 4) __builtin_amdgcn_s_setprio(1);
  if (q0 + wid * 32 >= L) {
    KLOAD(tbeg * KVBLK); VLOAD(tbeg * KVBLK); SWAIT(); KWRITE(0); VWRITE(0); __syncthreads();
    KLOAD((tbeg + 1) * KVBLK); SWAIT(); KWRITE(1); __syncthreads();
    for (int j = 1; j + 1 < NT; j += 2) {
      KLOAD((tbeg + j + 1) * KVBLK); VLOAD((tbeg + j) * KVBLK); SWAIT(); KWRITE(0); VWRITE(1); __syncthreads();
      const bool more = (j + 2 < NT);
      if (more) KLOAD((tbeg + j + 2) * KVBLK);
      VLOAD((tbeg + j + 1) * KVBLK); SWAIT(); if (more) KWRITE(1); VWRITE(0); __syncthreads();
    }
  } else {
  KLOAD(tbeg * KVBLK); VLOAD(tbeg * KVBLK); SWAIT(); KWRITE(0); VWRITE(0); __syncthreads();
  qkt(pA0, pA1, KN_lds, KR_lds, QR_lds, qr, negm, lane);
  KLOAD((tbeg + 1) * KVBLK);
  partialSM<true>(pA0, pA1, mhat, negm, alA);
  SWAIT(); KWRITE(1); __syncthreads();
  for (int j = 1; j + 1 < NT; j += 2) {
    SBAR(); qkt(pB0, pB1, KN_lds + SHM_KN, KR_lds + SHM_KR, QR_lds, qr, negm, lane);
    finishSM(pA0, pA1, alA, l_reg, pa0, pa1, pa2, pa3); SBAR();
    KLOAD((tbeg + j + 1) * KVBLK); VLOAD((tbeg + j) * KVBLK); SBAR();
    pv_d0(o, vb0, pa0, pa1, pa2, pa3); partialSM<false>(pB0, pB1, mhat, negm, alB);
    RESC(alB);
    SWAIT(); KWRITE(0); VWRITE(1); __syncthreads();
    SBAR(); qkt(pA0, pA1, KN_lds, KR_lds, QR_lds, qr, negm, lane);
    finishSM(pB0, pB1, alB, l_reg, pa0, pa1, pa2, pa3); SBAR();
    const bool more = (j + 2 < NT);
    if (more) KLOAD((tbeg + j + 2) * KVBLK);
    VLOAD((tbeg + j + 1) * KVBLK); SBAR();
    pv_d0(o, vb0 + SHM_V, pa0, pa1, pa2, pa3);
    if (tbeg + j + 1 == NTt - 1) kmask(pA0, pA1, nv_last, hi);
    partialSM<false>(pA0, pA1, mhat, negm, alA);
    RESC(alA);
    SWAIT(); if (more) KWRITE(1); VWRITE(0); __syncthreads();
  }
  finishSM(pA0, pA1, alA, l_reg, pa0, pa1, pa2, pa3); SBAR();
  pv_d0(o, vb0, pa0, pa1, pa2, pa3);
  }
  __builtin_amdgcn_s_setprio(0);
  int lane_e = lane, wid_e = wid, q0_e = q0, h_e = h, L_e = L; long row0_e = row0; char* lds_e = lds;
  asm volatile("" : "+v"(lane_e)); asm volatile("" : "+s"(wid_e), "+s"(q0_e), "+s"(h_e), "+s"(L_e), "+s"(row0_e), "+s"(lds_e));
  if (part != nullptr) {
    __syncthreads();
    if (wid_e == 0) { const int r32e = lane_e & 31, hie = lane_e >> 5;
#pragma unroll
      for (int r = 0; r < 8; ++r) { const int orow = crow(r, hie);
#pragma unroll
        for (int d0 = 0; d0 < 4; ++d0) part[(piece * 16 + orow) * 132 + d0 * 32 + r32e] = o[d0][r]; }
      if (lane_e < 16) { part[(piece * 16 + lane_e) * 132 + 128] = mhat; part[(piece * 16 + lane_e) * 132 + 129] = l_reg; } }
    __threadfence();
    __syncthreads();
    __attribute__((address_space(3))) unsigned* flag = (__attribute__((address_space(3))) unsigned*)(lds_e + OFF_FLAG);
    if (wid_e == 0 && lane_e == 0) { const unsigned old = __hip_atomic_fetch_add(cnt, 1u, __ATOMIC_RELAXED, __HIP_MEMORY_SCOPE_AGENT); *flag = old; }
    __syncthreads();
    const bool last = (*(volatile __attribute__((address_space(3))) unsigned*)flag == (unsigned)(NPIECE - 1));
    if (last) {
      __threadfence();
      const int t = wid_e * 64 + lane_e, row = t >> 5, c4 = (t & 31) * 4;
      float mmax = -3.0e38f;
#pragma unroll
      for (int i = 0; i < NPIECE; ++i) mmax = fmaxf(mmax, (*(part + (i * 16 + row) * 132 + 128)));
      float lsum = 0.f; float a0 = 0.f, a1 = 0.f, a2 = 0.f, a3 = 0.f;
#pragma unroll
      for (int i = 0; i < NPIECE; ++i) { const float* pr = part + (i * 16 + row) * 132;
        const float w = __builtin_amdgcn_exp2f((*(pr + 128)) - mmax); lsum += (*(pr + 129)) * w;
        a0 += (*(pr + c4)) * w; a1 += (*(pr + c4 + 1)) * w; a2 += (*(pr + c4 + 2)) * w; a3 += (*(pr + c4 + 3)) * w; }
      const float rl = 1.0f / lsum;
      const unsigned w0 = (unsigned)f2bf16(a0 * rl) | ((unsigned)f2bf16(a1 * rl) << 16), w1 = (unsigned)f2bf16(a2 * rl) | ((unsigned)f2bf16(a3 * rl) << 16);
      unsigned* dst = (unsigned*)(AO + (row0_e + q0_e + row) * 1024 + 128 * h_e + c4);
      dst[0] = w0; dst[1] = w1;
    }
    __syncthreads();
    return;
  }
  if (hi == 0) li_l[r32] = l_reg; asm volatile("s_waitcnt lgkmcnt(0)" ::: "memory");
  float rli[16];
#pragma unroll
  for (int r = 0; r < 16; ++r) rli[r] = __builtin_amdgcn_rcpf(li_l[crow(r, hi)]);
  __syncthreads();
  __attribute__((address_space(3))) unsigned short* stg = (__attribute__((address_space(3))) unsigned short*)(lds_e + wid_e * 8192);
  { const int r32e = lane_e & 31, hie = lane_e >> 5;
#pragma unroll
  for (int r = 0; r < 16; ++r) { const int orow = crow(r, hie);
#pragma unroll
    for (int d0 = 0; d0 < 4; ++d0) stg[orow * 128 + d0 * 32 + r32e] = f2bf16(o[d0][r] * rli[r]); } }
  asm volatile("s_waitcnt lgkmcnt(0)" ::: "memory");
  const int qw = q0_e + wid_e * 32;
  bf16* AOw = AO + (row0_e + qw) * 1024 + 128 * h_e + (lane_e & 15) * 8;
#pragma unroll
  for (int i = 0; i < 8; ++i) { const int row = i * 4 + (lane_e >> 4); const u32x4 v = *(const __attribute__((address_space(3))) u32x4*)(stg + row * 128 + (lane_e & 15) * 8);
    if (qw + row < L_e) *(u32x4*)(AOw + (long)row * 1024) = v; }
  asm volatile("s_waitcnt lgkmcnt(0)" ::: "memory");
  __syncthreads();
#undef KLOAD
#undef VLOAD
#undef KWRITE
#undef VWRITE
#undef SWAIT
#undef RESC
}
#undef SBAR
}


#define LAS __attribute__((address_space(3)))
typedef unsigned short bf16;
typedef unsigned v4u __attribute__((ext_vector_type(4)));
typedef unsigned v2u __attribute__((ext_vector_type(2)));
typedef float f32x4 __attribute__((ext_vector_type(4)));
constexpr int NWAVES = 8;
constexpr int LDS_BYTES = 147456;
constexpr int NPH = 1 + 8 * NLAYER;
constexpr int N_LAUNCHES = MK_N_LAUNCHES;

constexpr size_t MiB = 1u << 20;
constexpr size_t SZ_WIN = (size_t)NZ * 1024 * 2, SZ_WQ = 768 * 384 * 2, SZ_WKV = 1024 * 256 * 2, SZ_WO = 1024 * 1024 * 2, SZ_WGU = (size_t)5632 * 1024 * 2, SZ_WD = (size_t)1024 * 2816 * 2;
constexpr size_t OFFW_IN = 0, OFFW_Q = OFFW_IN + SZ_WIN, OFFW_KV = OFFW_Q + SZ_WQ, OFFW_O = OFFW_KV + SZ_WKV, OFFW_GU = OFFW_O + SZ_WO, OFFW_D = OFFW_GU + SZ_WGU, SZ_WLAYER = OFFW_D + SZ_WD;
constexpr size_t WS_CTL = 0, WS_BAR = 16384, WS_PART = 65536;
constexpr int LDS_BARST = 147456 - 64;
constexpr size_t WS_W = 1 * MiB, WS_ROPE = 50 * MiB, WS_SSQ = 55 * MiB, WS_SSQX = 63 * MiB + 512 * 1024, WS_X = 64 * MiB;
constexpr size_t WS_GB = 193 * MiB, WS_U = 257 * MiB + 512 * 1024, WS_ZQ = 322 * MiB, WS_AO = 322 * MiB, WS_F = 193 * MiB, WS_ACT1 = 322 * MiB;
constexpr int ACT_SPLIT = 138;
constexpr size_t WS_END = 512 * MiB;
constexpr size_t D_Q = 0, D_KN = (size_t)MP * 768 * 2, D_V = D_KN + (size_t)MP * 512 * 2, D_KR = D_V + (size_t)MP * 512 * 2, D_MIX = 0, D_ACT2 = 0;
static_assert(WS_W + 2 * SZ_WLAYER <= WS_ROPE && WS_ROPE + (size_t)L_S * 64 * 4 <= WS_SSQ && WS_SSQ + (size_t)MP * 32 * 4 <= WS_SSQX && WS_SSQX + (size_t)MP * 4 <= WS_X, "ws fixed region");
static_assert(WS_X + (size_t)MP * 1024 * 2 <= WS_GB && WS_GB + (size_t)MP * 512 * 2 <= WS_U && WS_U + (size_t)MP * 512 * 2 <= WS_ZQ && WS_ZQ + (size_t)MP * 768 * 2 <= WS_END, "ws map 1");
static_assert(WS_AO + (size_t)MP * 1024 * 2 <= WS_END && WS_F + (size_t)MP * 1024 * 2 <= WS_ACT1 && WS_ACT1 + (size_t)ACT_SPLIT * 256 * 2816 * 2 <= WS_END, "ws map 2");
static_assert(D_KR + (size_t)MP * 64 * 2 <= (size_t)256 * MiB && (size_t)(MP / 256 - ACT_SPLIT) * 256 * 2816 * 2 <= (size_t)256 * MiB && (size_t)MP * 1024 * 2 <= (size_t)256 * MiB, "d_out scratch map");

__device__ const double INVF[32] = {1.0, 0.7498942093324559, 0.5623413251903491, 0.4216965034285822, 0.31622776601683794, 0.23713737056616552, 0.1778279410038923, 0.1333521432163324, 0.1, 0.07498942093324558, 0.05623413251903491, 0.042169650342858224, 0.03162277660168379, 0.023713737056616554, 0.01778279410038923, 0.01333521432163324, 0.01, 0.007498942093324558, 0.005623413251903491, 0.004216965034285823, 0.0031622776601683794, 0.0023713737056616554, 0.0017782794100389228, 0.001333521432163324, 0.001, 0.0007498942093324559, 0.0005623413251903491, 0.00042169650342858224, 0.00031622776601683794, 0.00023713737056616554, 0.00017782794100389227, 0.0001333521432163324};

#define LDS_WAIT() asm volatile("s_waitcnt lgkmcnt(0)" ::: "memory")
__device__ __forceinline__ unsigned f2bf(float f) { unsigned u = __builtin_bit_cast(unsigned, f); return (u + 0x7fffu + ((u >> 16) & 1u)) >> 16; }
__device__ __forceinline__ unsigned pk2(float lo, float hi) { return f2bf(lo) | (f2bf(hi) << 16); }
__device__ __forceinline__ float bflo(unsigned w) { return __builtin_bit_cast(float, w << 16); }
__device__ __forceinline__ float bfhi(unsigned w) { return __builtin_bit_cast(float, w & 0xffff0000u); }
__device__ __forceinline__ float wave_sum(float v) {
#pragma unroll
    for (int o = 1; o < 64; o <<= 1) v += __shfl_xor(v, o);
    return v;
}
__device__ __forceinline__ float half_sum32(float v) {
#pragma unroll
    for (int o = 1; o < 32; o <<= 1) v += __shfl_xor(v, o);
    return v;
}

struct Args { const float* in[17]; float* out; unsigned char* ws; int ph_lo, ph_hi; };

__device__ __forceinline__ void p0_transpose_item(const float* W, int Nsrc, int K, int sc0, const float* g, bf16* WT, int dr0, int k0, LAS float* scr, int lane) {
    if (sc0 >= 0) {
#pragma unroll 8
        for (int i = 0; i < 32; ++i) { const int kk = 2 * i + (lane >> 5); const float gv = g ? g[k0 + kk] : 1.0f; scr[kk * 33 + (lane & 31)] = W[(size_t)(k0 + kk) * Nsrc + sc0 + (lane & 31)] * gv; }
    } else {
#pragma unroll 8
        for (int i = 0; i < 32; ++i) { const int kk = 2 * i + (lane >> 5); scr[kk * 33 + (lane & 31)] = 0.0f; }
    }
    LDS_WAIT(); asm volatile("" ::: "memory");
    const int c = lane & 7;
#pragma unroll
    for (int j = 0; j < 4; ++j) { const int n = (lane >> 3) + 8 * j; const LAS float* s = scr + (8 * c) * 33 + n;
        v4u o; o.x = pk2(s[0 * 33], s[1 * 33]); o.y = pk2(s[2 * 33], s[3 * 33]); o.z = pk2(s[4 * 33], s[5 * 33]); o.w = pk2(s[6 * 33], s[7 * 33]);
        *(v4u*)(WT + (size_t)(dr0 + n) * K + k0 + 8 * c) = o; }
    LDS_WAIT(); asm volatile("" ::: "memory");
}

__device__ __forceinline__ void p0_prologue(const Args& a, LAS unsigned char* lds, int gw, int NGW, int wave, int lane) {
    LAS float* scr = (LAS float*)(lds + wave * 16384);
    unsigned char* ws = a.ws;
    if (gw == 0 && lane < 2 * 8) ((unsigned*)(ws + WS_CTL))[lane * 64] = 0u;
    if (gw < NWAVES) { for (int i = gw * 64 + lane; i < 3456; i += NWAVES * 64) ((unsigned*)(ws + WS_BAR))[i] = 0u; }
    constexpr int I0 = 16 * 72, I1 = 6 * 24, I2 = 4 * 32, I3 = 16 * 32, I4 = 16 * 176, I5 = 44 * 32, IL = I0 + I1 + I2 + I3 + I4 + I5;
    for (int it = gw; it < NLAYER * IL; it += NGW) {
        const int l = it / IL; int r = it % IL;
        bf16* wl = (bf16*)(ws + WS_W + (size_t)l * SZ_WLAYER);
        if (r < I0) {
            const int kb = r / 72, nb = r % 72, n0 = nb * 32; int sc;
            if (n0 < 704) sc = n0; else if (n0 < 768) sc = -1; else if (n0 < 1280) sc = n0 - 64;
            else { const int t = (n0 - 1280) >> 8, w = (n0 - 1280) & 255; sc = (w < 128) ? 1216 + 128 * t + w : 1728 + 128 * t + (w - 128); }
            p0_transpose_item(a.in[4] + (size_t)l * 1024 * 2240, 2240, 1024, sc, a.in[3] + l * 1024, (bf16*)((unsigned char*)wl + OFFW_IN), n0, kb * 64, scr, lane); continue; }
        r -= I0;
        if (r < I1) {
            const int kb = r / 24, nb = r % 24, n0 = nb * 32; int sc;
            if (n0 < 512) sc = 192 * (n0 >> 7) + (n0 & 127); else if (n0 < 640) sc = 192 * ((n0 - 512) >> 5) + 128; else sc = 192 * ((n0 - 640) >> 5) + 160;
            p0_transpose_item(a.in[6] + (size_t)l * 384 * 768, 768, 384, sc, a.in[5] + l * 384, (bf16*)((unsigned char*)wl + OFFW_Q), n0, kb * 64, scr, lane); continue; }
        r -= I1;
        if (r < I2) {
            const int kb = r / 32, nb = r % 32, n0 = nb * 32; int sc;
            if (n0 < 512) sc = 256 * (n0 >> 7) + (n0 & 127); else sc = 256 * ((n0 - 512) >> 7) + 128 + ((n0 - 512) & 127);
            p0_transpose_item(a.in[8] + (size_t)l * 256 * 1024, 1024, 256, sc, a.in[7] + l * 256, (bf16*)((unsigned char*)wl + OFFW_KV), n0, kb * 64, scr, lane); continue; }
        r -= I2;
        if (r < I3) {
            const int kb = r / 32, nb = r % 32, n0 = nb * 32;
            p0_transpose_item(a.in[10] + (size_t)l * 1024 * 1024, 1024, 1024, n0, nullptr, (bf16*)((unsigned char*)wl + OFFW_O), n0, kb * 64, scr, lane); continue; }
        r -= I3;
        if (r < I4) {
            const int kb = r / 176, nb = r % 176, n0 = nb * 32; const int t = n0 >> 8, w = n0 & 255;
            const float* src = (w < 128) ? a.in[13] : a.in[14]; const int sc = 128 * t + (w & 127);
            p0_transpose_item(src + (size_t)l * 1024 * 2816, 2816, 1024, sc, a.in[12] + l * 1024, (bf16*)((unsigned char*)wl + OFFW_GU), n0, kb * 64, scr, lane); continue; }
        r -= I4;
        {
            const int kb = r / 32, nb = r % 32, n0 = nb * 32;
            p0_transpose_item(a.in[15] + (size_t)l * 2816 * 1024, 1024, 2816, n0, nullptr, (bf16*)((unsigned char*)wl + OFFW_D), n0, kb * 64, scr, lane); }
    }
    {
        float* rope = (float*)(ws + WS_ROPE);
        const int gt = gw * 64 + lane, NGT = NGW * 64;
        for (int idx = gt; idx < L_S * 32; idx += NGT) {
            const int pos = idx >> 5, i = idx & 31;
            const double ang = (double)pos * INVF[i];
            const double TWO_PI = 6.283185307179586476925286766559;
            const double kq = __builtin_rint(ang * (1.0 / TWO_PI));
            const double rr = __builtin_fma(-kq, TWO_PI, ang);
            const double x = rr * 0.125, x2 = x * x;
            double sn = x * (1.0 + x2 * (-1.0 / 6.0 + x2 * (1.0 / 120.0 + x2 * (-1.0 / 5040.0 + x2 * (1.0 / 362880.0 + x2 * (-1.0 / 39916800.0))))));
            double cs = 1.0 + x2 * (-0.5 + x2 * (1.0 / 24.0 + x2 * (-1.0 / 720.0 + x2 * (1.0 / 40320.0 + x2 * (-1.0 / 3628800.0 + x2 * (1.0 / 479001600.0))))));
#pragma unroll
            for (int d = 0; d < 3; ++d) { const double s2 = 2.0 * sn * cs, c2 = cs * cs - sn * sn; sn = s2; cs = c2; }
            rope[(size_t)pos * 64 + i] = (float)cs; rope[(size_t)pos * 64 + 32 + i] = (float)sn;
        }
    }
    {
        bf16* X = (bf16*)(ws + WS_X); float* ssqX = (float*)(ws + WS_SSQX);
        for (int r = gw; r < MP; r += NGW) {
            v2u* o8 = (v2u*)(X + (size_t)r * 1024) + lane;
            if (r >= M_REAL) {
#pragma unroll
                for (int j = 0; j < 4; ++j) o8[64 * j] = (v2u){0u, 0u};
                if (lane == 0) ssqX[r] = 0.0f;
                continue;
            }
            const float* src;
            if (r < ROWS_P) { const int s = r / L_P, pos = r - s * L_P; src = (pos < 16) ? a.in[2] + pos * 1024 : a.in[0] + ((size_t)s * 2048 + (pos - 16)) * 1024; }
            else { const int q = r - ROWS_P, s = q / L_S, pos = q - s * L_S; src = (pos < 16) ? a.in[2] + pos * 1024 : a.in[1] + ((size_t)s * 16384 + (pos - 16)) * 1024; }
            const f32x4* xr = (const f32x4*)src + lane;
            f32x4 v[4]; float s2 = 0.f;
#pragma unroll
            for (int j = 0; j < 4; ++j) { v[j] = xr[64 * j]; s2 += (v[j].x * v[j].x + v[j].y * v[j].y) + (v[j].z * v[j].z + v[j].w * v[j].w); }
            s2 = wave_sum(s2);
#pragma unroll
            for (int j = 0; j < 4; ++j) o8[64 * j] = (v2u){pk2(v[j].x, v[j].y), pk2(v[j].z, v[j].w)};
            if (lane == 0) ssqX[r] = s2;
        }
    }
}

__device__ __forceinline__ void kr_pass(const bf16* ZQ, const float* rope, bf16* KR, int gw, int NGW, int lane) {
    const int i = lane & 31;
    for (int r = gw; r < MP; r += NGW) {
        const int pos = pg8::row_pos(r);
        const bf16* z = ZQ + (size_t)r * 768 + 640;
        const float x1 = bflo((unsigned)z[i]), x2 = bflo((unsigned)z[32 + i]);
        const float c = rope[(size_t)pos * 64 + i], s = rope[(size_t)pos * 64 + 32 + i];
        const float y = (lane < 32) ? (x1 * c - x2 * s) : (x2 * c + x1 * s);
        KR[(size_t)r * 64 + lane] = (bf16)f2bf(y);
    }
}
__device__ __forceinline__ void conv_pass(const bf16* GB, const bf16* U, const float* cw  , bf16* AO, int gw, int NGW, int lane) {
    const int c0 = lane * 8;
    f32x4 w[3][2];
#pragma unroll
    for (int k = 0; k < 3; ++k) { w[k][0] = *(const f32x4*)(cw + k * 512 + c0); w[k][1] = *(const f32x4*)(cw + k * 512 + c0 + 4); }
    for (int r = gw; r < MP; r += NGW) {
        v4u* dst = (v4u*)(AO + (size_t)r * 1024 + 512 + c0);
        if (r >= M_REAL) { *dst = (v4u){0u, 0u, 0u, 0u}; *(v4u*)(AO + (size_t)r * 1024 + c0) = (v4u){0u, 0u, 0u, 0u}; continue; }
        int pos, L;
        if (r < ROWS_P) { pos = r % L_P; L = L_P; } else { pos = (r - ROWS_P) % L_S; L = L_S; }
        const v4u g = *(const v4u*)(GB + (size_t)r * 512 + c0);
        const v4u u1 = *(const v4u*)(U + (size_t)r * 512 + c0);
        v4u u0 = (v4u){0u, 0u, 0u, 0u}, u2 = (v4u){0u, 0u, 0u, 0u};
        if (pos > 0) u0 = *(const v4u*)(U + (size_t)(r - 1) * 512 + c0);
        if (pos < L - 1) u2 = *(const v4u*)(U + (size_t)(r + 1) * 512 + c0);
        v4u o;
#pragma unroll
        for (int q = 0; q < 4; ++q) {
            const int h = q >> 1, e = (q & 1) * 2;
            const float lo = bflo(g[q]) * (w[0][h][e] * bflo(u0[q]) + w[1][h][e] * bflo(u1[q]) + w[2][h][e] * bflo(u2[q]));
            const float hi = bfhi(g[q]) * (w[0][h][e + 1] * bfhi(u0[q]) + w[1][h][e + 1] * bfhi(u1[q]) + w[2][h][e + 1] * bfhi(u2[q]));
            o[q] = pk2(lo, hi);
        }
        *dst = o;
    }
}
__device__ __forceinline__ void nr_pass(bf16* X, const bf16* Y, const float* SSQ, float* ssqX, const float* g, float* out  , int gw, int NGW, int lane) {
    f32x4 gv[4];
#pragma unroll
    for (int j = 0; j < 4; ++j) gv[j] = *((const f32x4*)g + lane + 64 * j);
    for (int r = gw; r < M_REAL; r += NGW) {
        const float part = SSQ[(size_t)r * 32 + (lane & 31)];
        const float s = rsqrtf(half_sum32(part) * (1.0f / 1024.0f) + EPS);
        v2u* x8 = (v2u*)(X + (size_t)r * 1024) + lane; const v2u* y8 = (const v2u*)(Y + (size_t)r * 1024) + lane;
        f32x4 v[4]; float s2 = 0.f;
#pragma unroll
        for (int j = 0; j < 4; ++j) { const v2u xv = x8[64 * j], yv = y8[64 * j];
            v[j].x = bflo(xv.x) + bflo(yv.x) * s * gv[j].x; v[j].y = bfhi(xv.x) + bfhi(yv.x) * s * gv[j].y;
            v[j].z = bflo(xv.y) + bflo(yv.y) * s * gv[j].z; v[j].w = bfhi(xv.y) + bfhi(yv.y) * s * gv[j].w;
            s2 += (v[j].x * v[j].x + v[j].y * v[j].y) + (v[j].z * v[j].z + v[j].w * v[j].w); }
        if (out == nullptr) {
            s2 = wave_sum(s2);
#pragma unroll
            for (int j = 0; j < 4; ++j) x8[64 * j] = (v2u){pk2(v[j].x, v[j].y), pk2(v[j].z, v[j].w)};
            if (lane == 0) ssqX[r] = s2;
        } else {
            int pos; size_t orow;
            if (r < ROWS_P) { const int sq = r / L_P; pos = r - sq * L_P; orow = (size_t)sq * 2048 + (pos - 16); }
            else { const int q = r - ROWS_P, sq = q / L_S; pos = q - sq * L_S; orow = (size_t)NSEQ_P * 2048 + (size_t)sq * 16384 + (pos - 16); }
            if (pos >= 16) { f32x4* o = (f32x4*)(out + orow * 1024) + lane;
#pragma unroll
                for (int j = 0; j < 4; ++j) o[64 * j] = v[j]; }
        }
    }
}

constexpr int NU_S = 512, NU_PC = 56, NU_P = 576, NU = NU_S + NU_PC + NU_P;
__device__ __forceinline__ int attn_next(int i, int G, int bx) {
    if (G == 256) {
        const int vcu = (bx & 7) * 32 + (bx >> 3), x = vcu >> 5, c = vcu & 31;
        if (i == 0) return 64 * x + c;
        if (i == 1) return 64 * x + 32 + c;
        if (i < 4) { const int f = c + 32 * (i - 2); return NU_S + NU_PC + 72 * x + (f >> 3) * 9 + (f & 7); }
        if (i == 4 && c < 15) return (c < 8) ? NU_S + NU_PC + 72 * x + c * 9 + 8 : NU_S + 7 * x + (c - 8);
        return -1;
    }
    const int id = i * G + bx; return (id < NU) ? id : -1;
}

#define XB_TMO      128
#define XB_XCNT(j)  (256  + 64 * (j))
#define XB_XSUB(j)  (1280 + 64 * (j))
#define XB_XGEN(j)  (2304 + 64 * (j))
#define XB_TOP      3328
#define XB_TOPGEN   3392
#define XCD_BAR_WORDS 3456
#define XB_SPIN_CAP (1u << 18)

__device__ __forceinline__ unsigned xb_ld(unsigned* p)              { return __hip_atomic_load(p, __ATOMIC_RELAXED, __HIP_MEMORY_SCOPE_AGENT); }
__device__ __forceinline__ unsigned xb_add(unsigned* p, unsigned v) { return __hip_atomic_fetch_add(p, v, __ATOMIC_RELAXED, __HIP_MEMORY_SCOPE_AGENT); }
__device__ __forceinline__ unsigned xb_xcc_id() { return (unsigned)__builtin_amdgcn_s_getreg((3 << 11) | 20) & 0xFu; }
#define XB_SPIN(cond, bar) do { unsigned _sp = 0; while (cond) { __builtin_amdgcn_s_sleep(1); \
    if ((++_sp & 255u) == 0u) { if (xb_ld(&(bar)[XB_TMO])) break; if (_sp > XB_SPIN_CAP) { atomicAdd(&(bar)[XB_TMO], 1u); break; } } } } while (0)

struct XcdBarrier {
    unsigned* bar; unsigned x;
    volatile LAS unsigned* st;
};

__device__ __forceinline__ XcdBarrier xcd_barrier_post(unsigned* bar, volatile LAS unsigned* st) {
    XcdBarrier b; b.bar = bar; b.x = xb_xcc_id(); b.st = st;
    if (threadIdx.x == 0) (void)xb_add(&bar[XB_XCNT(b.x)], 1u);
    return b;
}
__device__ __forceinline__ void xcd_barrier_complete(unsigned* bar, unsigned x, unsigned& nloc, unsigned& nx) {
    const unsigned G = gridDim.x * gridDim.y * gridDim.z;
    unsigned sum, cnt, mine, sp = 0u;
    for (;;) {
        sum = 0u; cnt = 0u; mine = 0u;
#pragma unroll
        for (unsigned j = 0; j < 16; ++j) { const unsigned c = xb_ld(&bar[XB_XCNT(j)]); sum += c; cnt += (c > 0u) ? 1u : 0u; mine = (j == x) ? c : mine; }
        if (sum == G) break;
        __builtin_amdgcn_s_sleep(1);
        if ((++sp & 255u) == 0u) { if (xb_ld(&bar[XB_TMO])) break; if (sp > XB_SPIN_CAP) { atomicAdd(&bar[XB_TMO], 1u); break; } }
    }
    nloc = mine > 0u ? mine : 1u; nx = cnt > 0u ? cnt : 1u;
}

__device__ __forceinline__ void xcd_barrier(const XcdBarrier& b) {
    asm volatile("s_waitcnt vmcnt(0)" ::: "memory");
    __syncthreads();
    if (threadIdx.x == 0) {
        unsigned* bar = b.bar;
        __builtin_amdgcn_s_waitcnt(0);
        unsigned nloc = b.st[0], nx = b.st[1];
        if (nloc == 0u) { xcd_barrier_complete(bar, b.x, nloc, nx); b.st[0] = nloc; b.st[1] = nx; }
        const unsigned old = xb_add(&bar[XB_XSUB(b.x)], 1u);
        const unsigned gen = old / nloc;
        if (old + 1u == (gen + 1u) * nloc) {
            __builtin_amdgcn_fence(__ATOMIC_RELEASE, "agent");
            asm volatile("s_waitcnt vmcnt(0)" ::: "memory");
            const unsigned og = xb_add(&bar[XB_TOP], 1u);
            const unsigned tg = og / nx;
            if (og + 1u == (tg + 1u) * nx) xb_add(&bar[XB_TOPGEN], 1u);
            else XB_SPIN(xb_ld(&bar[XB_TOPGEN]) == tg, bar);
            __builtin_amdgcn_fence(__ATOMIC_ACQUIRE, "agent");
            xb_add(&bar[XB_XGEN(b.x)], 1u);
            asm volatile("s_waitcnt vmcnt(0)" ::: "memory");
        } else {
            XB_SPIN(xb_ld(&bar[XB_XGEN(b.x)]) == gen, bar);
            __builtin_amdgcn_fence(__ATOMIC_ACQUIRE, "agent");
            asm volatile("s_waitcnt vmcnt(0)" ::: "memory");
        }
    }
    __syncthreads();
}

__device__ __forceinline__ int attn_next_last(int i, int G, int bx) {
    if (G == 256) {
        const int vcu = (bx & 7) * 32 + (bx >> 3), x = vcu >> 5, c = vcu & 31;
        if (i == 0) return 64 * x + c;
        if (i == 1) return 64 * x + 32 + c;
        if (i < 4) return 512 + 64 * x + c + 32 * (i - 2);
        return -1;
    }
    const int id = i * G + bx; return (id < 1024) ? id : -1;
}

#define GAS __attribute__((address_space(1)))
#define LAUNDER_BASES() GAS unsigned char* wsg_ = (GAS unsigned char*)a.ws; GAS unsigned char* dsg_ = (GAS unsigned char*)a.out; asm volatile("" : "+s"(wsg_), "+s"(dsg_)); \
    unsigned char* ws = (unsigned char*)wsg_; unsigned char* dsc = (unsigned char*)dsg_;     \
    int lane = threadIdx.x & 63, wave = __builtin_amdgcn_readfirstlane(threadIdx.x >> 6), G = gridDim.x, bx = blockIdx.x; \
    asm volatile("" : "+v"(lane)); asm volatile("" : "+s"(wave), "+s"(G), "+s"(bx)); \
    const int gw = bx * NWAVES + wave, NGW = G * NWAVES; (void)gw; (void)NGW; (void)lane; (void)dsc
#define P_X ((bf16*)(ws + WS_X))
#define P_GB ((bf16*)(ws + WS_GB))
#define P_U ((bf16*)(ws + WS_U))
#define P_ZQ ((bf16*)(ws + WS_ZQ))
#define P_AO ((bf16*)(ws + WS_AO))
#define P_F ((bf16*)(ws + WS_F))
#define P_ACT1 ((bf16*)(ws + WS_ACT1))
#define P_ACT2 ((bf16*)(dsc + D_ACT2))
#define P_Q ((bf16*)(dsc + D_Q))
#define P_KN ((bf16*)(dsc + D_KN))
#define P_V ((bf16*)(dsc + D_V))
#define P_KR ((bf16*)(dsc + D_KR))
#define P_MIX ((bf16*)(dsc + D_MIX))
#define P_SSQ ((float*)(ws + WS_SSQ))
#define P_SSQX ((float*)(ws + WS_SSQX))
#define P_ROPE ((const float*)(ws + WS_ROPE))
#define PH_IN(p) (lo <= (p) && (p) < hi && ((PHM >> ((p) == 0 ? 0 : (((p) - 1) & 7) + 1)) & 1))
#define PH_SYNC(p) do { if (lo <= (p) && (p) + 1 < hi) xcd_barrier(bar); } while (0)

template <int LYR>
__device__ __forceinline__ void layer_phases(const Args& a, const XcdBarrier& bar, unsigned char* lds, int lo, int hi) {
    LAS unsigned char* ldsl = (LAS unsigned char*)lds;
    constexpr int P0 = 1 + 8 * LYR;
    constexpr size_t WOFF = WS_W + (size_t)LYR * SZ_WLAYER;
    if (PH_IN(P0 + 0)) {
        LAUNDER_BASES();
        pg8::Gemm g{P_X, P_X, 1 << 30, (const bf16*)(ws + WOFF + OFFW_IN), MP, NZ, 1024, 1024}; pg8::StaticOrder S; S.init(MP, NZ, G, bx);
        pg8::EpiZ E{P_ZQ, P_GB, P_U, P_SSQ, P_SSQX};
        pg8::gemm_phase<pg8::EpiZ, pg8::StaticOrder, true, true>(ldsl, g, S, E);
    }
    PH_SYNC(P0 + 0);
    if (PH_IN(P0 + 1)) {
        { LAUNDER_BASES();
          pg8::Gemm g{P_ZQ, P_ZQ, 1 << 30, (const bf16*)(ws + WOFF + OFFW_Q), MP, 768, 384, 768}; pg8::StaticOrder S; S.init(MP, 768, G, bx);
          pg8::EpiQ E{P_Q, P_SSQ, P_ROPE};
          pg8::gemm_phase<pg8::EpiQ, pg8::StaticOrder, true, true>(ldsl, g, S, E); }
        { LAUNDER_BASES();
          pg8::Gemm g{P_ZQ + 384, P_ZQ + 384, 1 << 30, (const bf16*)(ws + WOFF + OFFW_KV), MP, 1024, 256, 768}; pg8::StaticOrder S; S.init(MP, 1024, G, (bx + 128) % G);
          pg8::EpiKV E{P_KN, P_V, P_SSQ};
          pg8::gemm_phase<pg8::EpiKV, pg8::StaticOrder, true, true>(ldsl, g, S, E); }
        { LAUNDER_BASES(); kr_pass(P_ZQ, P_ROPE, P_KR, gw, NGW, lane); }
    }
    PH_SYNC(P0 + 1);
    if (PH_IN(P0 + 2)) {
        { LAUNDER_BASES(); conv_pass(P_GB, P_U, a.in[9] + (size_t)LYR * 3 * 512, P_AO, gw, NGW, lane); }
        __syncthreads();
        { LAUNDER_BASES();
          for (int i = 0;; ++i) {
            constexpr bool LASTL = (LYR == NLAYER - 1);
            const int id = LASTL ? attn_next_last(i, G, bx) : attn_next(i, G, bx); if (id < 0) break;
            long row0; int L, h, qb, tbeg = 0, nt; float* part = nullptr; unsigned* cnt = nullptr; int piece = 0;
            if (LASTL) {
                if (id < 512) { const int pair = id >> 6; qb = id & 63; h = pair & 3; row0 = ROWS_P + (long)(pair >> 2) * L_S; L = L_S; nt = 257; }
                else { const int e = id - 512, pair = e >> 3; qb = e & 7; h = pair & 3; row0 = (long)(pair >> 2) * L_P; L = L_P; nt = 33; }
            } else if (id < NU_S) { const int pair = id >> 6; qb = id & 63; h = pair & 3; row0 = ROWS_P + (long)(pair >> 2) * L_S; L = L_S; nt = 257; }
            else if (id < NU_S + NU_PC) { const int k = id - NU_S, pair = k / 7; piece = k - pair * 7; qb = 64; h = pair & 3; row0 = ROWS_P + (long)(pair >> 2) * L_S; L = L_S;
                tbeg = 37 * piece; nt = (piece == 6) ? 35 : 37; part = (float*)(ws + WS_PART) + (size_t)pair * att::NPIECE * 16 * 132; cnt = (unsigned*)(ws + WS_CTL) + (LYR * 8 + pair) * 64; }
            else { const int e = id - NU_S - NU_PC, pair = e / 9; qb = e - pair * 9; h = pair & 3; row0 = (long)(pair >> 2) * L_P; L = L_P; nt = 33; }
            att::attn_unit(P_Q, P_KN, P_KR, P_V, P_AO, row0, L, h, qb * 256 + (LASTL ? 16 : 0), (char*)lds, tbeg, nt, part, cnt, piece);
          } }
    }
    PH_SYNC(P0 + 2);
    if (PH_IN(P0 + 3)) {
        LAUNDER_BASES();
        pg8::Gemm g{P_AO, P_AO, 1 << 30, (const bf16*)(ws + WOFF + OFFW_O), MP, 1024, 1024, 1024}; pg8::StaticOrder S; S.init(MP, 1024, G, bx);
        pg8::EpiMix E{P_MIX, P_SSQ};
        pg8::gemm_phase<pg8::EpiMix, pg8::StaticOrder, true, true>(ldsl, g, S, E);
    }
    PH_SYNC(P0 + 3);
    if (PH_IN(P0 + 4)) {
        LAUNDER_BASES(); nr_pass(P_X, P_MIX, P_SSQ, P_SSQX, a.in[11] + LYR * 1024, nullptr, gw, NGW, lane);
    }
    PH_SYNC(P0 + 4);
    if (PH_IN(P0 + 5)) {
        LAUNDER_BASES();
        pg8::Gemm g{P_X, P_X, 1 << 30, (const bf16*)(ws + WOFF + OFFW_GU), MP, 5632, 1024, 1024}; pg8::StaticOrder S; S.init(MP, 5632, G, bx);
        pg8::EpiAct E{P_ACT1, P_ACT2, ACT_SPLIT, P_SSQX};
        pg8::gemm_phase<pg8::EpiAct, pg8::StaticOrder, true, true>(ldsl, g, S, E);
    }
    PH_SYNC(P0 + 5);
    if (PH_IN(P0 + 6)) {
        LAUNDER_BASES();
        pg8::Gemm g{P_ACT1, P_ACT2, ACT_SPLIT, (const bf16*)(ws + WOFF + OFFW_D), MP, 1024, 2816, 2816}; pg8::StaticOrder S; S.init(MP, 1024, G, bx);
        pg8::EpiMix E{P_F, P_SSQ};
        pg8::gemm_phase<pg8::EpiMix, pg8::StaticOrder, true, true>(ldsl, g, S, E);
    }
    PH_SYNC(P0 + 6);
    if (PH_IN(P0 + 7)) {
        LAUNDER_BASES(); nr_pass(P_X, P_F, P_SSQ, P_SSQX, a.in[16] + LYR * 1024, (LYR == NLAYER - 1) ? a.out : nullptr, gw, NGW, lane);
    }
    PH_SYNC(P0 + 7);
}

__global__ void __launch_bounds__(NWAVES * 64, 2) mega_fwd(Args a) {
    extern __shared__ __attribute__((aligned(16))) unsigned char lds[];
    cg::grid_group grid = cg::this_grid();
    const int lo = a.ph_lo, hi = a.ph_hi;
    volatile LAS unsigned* barst = (volatile LAS unsigned*)((LAS unsigned char*)lds + LDS_BARST);
    if (threadIdx.x == 0) { barst[0] = 0u; barst[1] = 0u; }
    __syncthreads();
    if (PH_IN(0)) { LAUNDER_BASES(); p0_prologue(a, (LAS unsigned char*)lds, gw, NGW, wave, lane); }
    XcdBarrier bar; bar.bar = nullptr; bar.x = 0; bar.st = barst;
    if (lo <= 0 && 1 < hi) {
        grid.sync();
        bar = xcd_barrier_post((unsigned*)(a.ws + WS_BAR), barst);
    }
    layer_phases<0>(a, bar, lds, lo, hi);
    layer_phases<1>(a, bar, lds, lo, hi);
}

extern "C" void kernel_launch(void* const* d_in, const int* in_sizes, int n_in, void* d_out, int out_size, void* d_ws, size_t ws_size, hipStream_t stream) {
    static int grid = 0;
    if (grid == 0) {
        if (n_in != 17 || in_sizes[0] != 16 * 2048 * 1024 || in_sizes[1] != 2 * 16384 * 1024 || out_size != 65536 * 1024 || ws_size < WS_END) {
            fprintf(stderr, "kernel_launch: unexpected shapes / workspace (n_in %d, ws %zu, need %zu); nothing launched\n", n_in, ws_size, (size_t)WS_END); grid = -1; return; }
        int dev = 0, cus = 0, per_cu = 0;
        if (hipGetDevice(&dev) != hipSuccess || hipDeviceGetAttribute(&cus, hipDeviceAttributeMultiprocessorCount, dev) != hipSuccess) { grid = -1; return; }
        if (hipFuncSetAttribute((const void*)mega_fwd, hipFuncAttributeMaxDynamicSharedMemorySize, LDS_BYTES) != hipSuccess) { fprintf(stderr, "kernel_launch: hipFuncSetAttribute failed\n"); grid = -1; return; }
        if (hipOccupancyMaxActiveBlocksPerMultiprocessor(&per_cu, (const void*)mega_fwd, NWAVES * 64, LDS_BYTES) != hipSuccess || per_cu < 1) { fprintf(stderr, "kernel_launch: occupancy query failed (%d)\n", per_cu); per_cu = 1; }
        (void)hipGetLastError();
        grid = cus * per_cu;
    }
    if (grid < 0) return;
    Args a{};
    for (int i = 0; i < 17; ++i) a.in[i] = (const float*)d_in[i];
    a.out = (float*)d_out; a.ws = (unsigned char*)d_ws;
    if (N_LAUNCHES == 1) {
        a.ph_lo = 0; a.ph_hi = NPH;
        void* args[] = {&a};
        hipError_t e = hipLaunchCooperativeKernel((void*)mega_fwd, dim3(grid), dim3(NWAVES * 64), args, LDS_BYTES, stream);
        if (e != hipSuccess) fprintf(stderr, "kernel_launch: cooperative launch failed: %s (grid %d)\n", hipGetErrorString(e), grid);
    } else {
        for (int ph = 0; ph < NPH; ++ph) {
            a.ph_lo = ph; a.ph_hi = ph + 1;
            hipLaunchKernelGGL(mega_fwd, dim3(grid), dim3(NWAVES * 64), LDS_BYTES, stream, a);
        }
    }
}
```
